# Optimizing an MI355X kernel written in HIP

```python
import jax, jax.numpy as jnp
from jax import lax
import numpy as np

D_MODEL = 1024
BATCH = 8
SEQ = 2048
DEPTH = 2

CTX_LEN = 256
GRID_W = 64
EXPAND = 2
D_INNER = EXPAND * D_MODEL
HG_KEY_DIM = 128
HG_HEADS = D_INNER // HG_KEY_DIM
HG_VAL_DIM = D_INNER // HG_HEADS
HG_CHUNK = 64
RG_BLOCK = 256
RG_HEADS = D_INNER // RG_BLOCK
RG_CONV_W = 4
RG_C = 8.0
N_HG = (DEPTH + 1) // 2
N_RG = DEPTH // 2
EPS = 1e-6

kernel_name = 'hybrid_hgrn2_rglru_prefix_dit'

F32 = jnp.float32


def _rms(x, g):
    xf = x.astype(F32)
    return xf * lax.rsqrt(jnp.mean(xf * xf, axis=-1, keepdims=True) + EPS) * g.astype(F32)


def _heads(a):
    B, T, _ = a.shape
    return a.reshape(B, T, HG_HEADS, -1).transpose(0, 2, 1, 3)


def _hgrn2_chunk_scan(q, k, logf, v, s0):
    B, H, T, K = q.shape
    V = v.shape[-1]
    n = T // HG_CHUNK

    def chunks(a):
        return a.reshape(B, H, n, HG_CHUNK, a.shape[-1]).transpose(2, 0, 1, 3, 4)

    lower_tri = jnp.tril(jnp.ones((HG_CHUNK, HG_CHUNK), dtype=bool))[:, :, None]

    def step(S, inp):
        qc, kc, gc, vc = inp
        b = jnp.cumsum(gc, axis=2)
        diff = b[:, :, :, None, :] - b[:, :, None, :, :]
        decay = jnp.exp(jnp.where(lower_tri, diff, -jnp.inf))
        scores = jnp.einsum('bhtk,bhsk,bhtsk->bhts', qc, kc, decay)
        o = (jnp.einsum('bhts,bhsv->bhtv', scores, vc)
             + jnp.einsum('bhtk,bhkv->bhtv', qc * jnp.exp(b), S))
        b_last = b[:, :, -1:, :]
        S = (jnp.exp(b_last[:, :, 0, :])[..., None] * S
             + jnp.einsum('bhsk,bhsv->bhkv', kc * jnp.exp(b_last - b), vc))
        return S, o

    S, o = lax.scan(step, s0, (chunks(q), chunks(k), chunks(logf), chunks(v)))
    o = o.transpose(1, 2, 0, 3, 4).reshape(B, H, T, V)
    return o, S


def hgrn2_mixer(h_ctx, h_lat, w_in, lb, norm_g, w_out, need_ctx):
    def prep(hh):
        q, v, zf, zb, g = jnp.split(hh @ w_in, 5, axis=-1)
        q = jax.nn.silu(q.astype(F32))

        def forget(z):
            f = lb + (1.0 - lb) * jax.nn.sigmoid(z.astype(F32))
            return _heads(jnp.log(f)), _heads(1.0 - f)

        return _heads(q), _heads(v.astype(F32)), forget(zf), forget(zb), g

    def run(q, k, logf, v, s0, reverse):
        if reverse:
            q, k, logf, v = (jnp.flip(a, axis=2) for a in (q, k, logf, v))
        o, s = _hgrn2_chunk_scan(q, k, logf, v, s0)
        if reverse:
            o = jnp.flip(o, axis=2)
        return o, s

    def readout(o, g):
        B, H, T, V = o.shape
        o = _rms(o.transpose(0, 2, 1, 3), norm_g.reshape(H, V)).reshape(B, T, H * V)
        o = o * jax.nn.silu(g.astype(F32))
        return o.astype(w_out.dtype) @ w_out

    B = h_lat.shape[0]
    s0 = jnp.zeros((B, HG_HEADS, HG_KEY_DIM, HG_VAL_DIM), F32)
    qc, vc, (gcf, kcf), (gcb, kcb), g_c = prep(h_ctx)
    ocf, sf = run(qc, kcf, gcf, vc, s0, False)
    ocb, sb = run(qc, kcb, gcb, vc, s0, True)
    ql, vl, (glf, klf), (glb, klb), g_l = prep(h_lat)
    olf, _ = run(ql, klf, glf, vl, sf, False)
    olb, _ = run(ql, klb, glb, vl, sb, True)
    y = readout(olf + olb, g_l)
    yc = readout(ocf + ocb, g_c) if need_ctx else None
    return yc, y


def _conv_centred(xb, conv_w, conv_b):
    E = xb.shape[-1]
    y = lax.conv_general_dilated(xb, conv_w[:, None, :].astype(xb.dtype), window_strides=(1,),
                                 padding=[(2, 1)], dimension_numbers=('NWC', 'WIO', 'NWC'),
                                 feature_group_count=E)
    return y + conv_b


def _linear_scan(a, u, h0):
    def combine(l, r):
        return (l[0] * r[0], r[0] * l[1] + r[1])
    A, Bv = lax.associative_scan(combine, (a, u), axis=1)
    return A * h0[:, None, :] + Bv


def rglru_mixer(h_ctx, h_lat, w_in, conv_w, conv_b, w_a, b_a, w_x, b_x, lam, w_out, need_ctx):
    B, T, _ = h_lat.shape
    rows = T // GRID_W
    h_lat = h_lat.reshape(B, rows, GRID_W, -1).transpose(0, 2, 1, 3).reshape(B, T, -1)

    def prep(hh):
        xb, g = jnp.split(hh @ w_in, 2, axis=-1)
        return _conv_centred(xb, conv_w, conv_b).astype(F32), g

    def coeffs(xb, d):
        Bq, Tq, _ = xb.shape
        xh = xb.reshape(Bq, Tq, RG_HEADS, RG_BLOCK)
        r = jax.nn.sigmoid(jnp.einsum('bthi,hij->bthj', xh, w_a[d].astype(F32)).reshape(Bq, Tq, D_INNER)
                           + b_a[d].astype(F32))
        ig = jax.nn.sigmoid(jnp.einsum('bthi,hij->bthj', xh, w_x[d].astype(F32)).reshape(Bq, Tq, D_INNER)
                            + b_x[d].astype(F32))
        log_a = -RG_C * r * jax.nn.softplus(-lam[d].astype(F32))
        a = jnp.exp(log_a)
        u = jnp.sqrt(-jnp.expm1(2.0 * log_a)) * (ig * xb)
        return a, u

    def run(a, u, h0, reverse):
        if reverse:
            a, u = jnp.flip(a, axis=1), jnp.flip(u, axis=1)
        h = _linear_scan(a, u, h0)
        last = h[:, -1]
        if reverse:
            h = jnp.flip(h, axis=1)
        return h, last

    def readout(hsum, g):
        return (hsum * jax.nn.silu(g.astype(F32))).astype(w_out.dtype) @ w_out

    h0 = jnp.zeros((B, D_INNER), F32)
    xc, g_c = prep(h_ctx)
    ycf, hf = run(*coeffs(xc, 0), h0, False)
    ycb, hb = run(*coeffs(xc, 1), h0, True)
    xl, g_l = prep(h_lat)
    ylf, _ = run(*coeffs(xl, 0), hf, False)
    ylb, _ = run(*coeffs(xl, 1), hb, True)
    y = readout(ylf + ylb, g_l)
    y = y.reshape(B, GRID_W, rows, -1).transpose(0, 2, 1, 3).reshape(B, T, -1)
    yc = readout(ycf + ycb, g_c) if need_ctx else None
    return yc, y


def setup_inputs(seed: int = 0) -> dict:
    key = jax.random.key(seed)
    ks = jax.random.split(key, 24)
    n = jax.random.normal
    D, E = D_MODEL, D_INNER
    u = jax.random.uniform(ks[21], (N_RG, 2, E), minval=0.9, maxval=0.999)
    s = u ** (1.0 / RG_C)
    return {
        'x': n(ks[0], (BATCH, SEQ, D), F32),
        'c': n(ks[1], (BATCH, D), F32),
        'ctx': n(ks[2], (BATCH, CTX_LEN, D), F32),
        'c_ctx': n(ks[3], (D,), F32),
        'ada_w': n(ks[4], (DEPTH, D, 3 * D), F32) * (0.5 * D ** -0.5),
        'ada_b': n(ks[5], (DEPTH, 3 * D), F32) * 0.02,
        'norm_g': 1.0 + 0.02 * n(ks[6], (DEPTH, D), F32),
        'final_norm_g': 1.0 + 0.02 * n(ks[7], (D,), F32),
        'hg_w_in': n(ks[8], (N_HG, D, 5 * E), F32) * D ** -0.5,
        'hg_lower_bounds': n(ks[9], (DEPTH + 1, E), F32) * 0.5,
        'hg_norm_g': 1.0 + 0.02 * n(ks[10], (N_HG, E), F32),
        'hg_w_out': n(ks[11], (N_HG, E, D), F32) * E ** -0.5,
        'rg_w_in': n(ks[12], (N_RG, D, 2 * E), F32) * D ** -0.5,
        'rg_conv_w': n(ks[13], (N_RG, RG_CONV_W, E), F32) * RG_CONV_W ** -0.5,
        'rg_conv_b': n(ks[14], (N_RG, E), F32) * 0.02,
        'rg_w_a': n(ks[15], (N_RG, 2, RG_HEADS, RG_BLOCK, RG_BLOCK), F32) * RG_BLOCK ** -0.5,
        'rg_b_a': n(ks[16], (N_RG, 2, E), F32) * 0.02,
        'rg_w_x': n(ks[17], (N_RG, 2, RG_HEADS, RG_BLOCK, RG_BLOCK), F32) * RG_BLOCK ** -0.5,
        'rg_b_x': n(ks[18], (N_RG, 2, E), F32) * 0.02,
        'rg_lambda': jnp.log(s) - jnp.log1p(-s),
        'rg_w_out': n(ks[19], (N_RG, E, D), F32) * E ** -0.5,
    }


def reference(x, c, ctx, c_ctx, ada_w, ada_b, norm_g, final_norm_g, hg_w_in, hg_lower_bounds,
              hg_norm_g, hg_w_out, rg_w_in, rg_conv_w, rg_conv_b, rg_w_a, rg_b_a, rg_w_x, rg_b_x,
              rg_lambda, rg_w_out):
    sc = jax.nn.silu(c)
    scc = jax.nn.silu(c_ctx)
    lb_all = jnp.cumsum(jax.nn.softmax(hg_lower_bounds.astype(F32), axis=0), axis=0)
    for i in range(DEPTH):
        shift, scale, gate = jnp.split(sc @ ada_w[i] + ada_b[i], 3, axis=-1)
        shift_c, scale_c, gate_c = jnp.split(scc @ ada_w[i] + ada_b[i], 3, axis=-1)
        h = (_rms(x, norm_g[i]) * (1.0 + scale[:, None]) + shift[:, None]).astype(x.dtype)
        hc = (_rms(ctx, norm_g[i]) * (1.0 + scale_c) + shift_c).astype(ctx.dtype)
        need_ctx = i < DEPTH - 1
        j = i // 2
        if i % 2 == 0:
            yc, y = hgrn2_mixer(hc, h, hg_w_in[j], lb_all[i], hg_norm_g[j], hg_w_out[j], need_ctx)
        else:
            yc, y = rglru_mixer(hc, h, rg_w_in[j], rg_conv_w[j], rg_conv_b[j], rg_w_a[j], rg_b_a[j],
                                rg_w_x[j], rg_b_x[j], rg_lambda[j], rg_w_out[j], need_ctx)
        x = (x + gate[:, None] * y).astype(x.dtype)
        if need_ctx:
            ctx = (ctx + gate_c * yc).astype(ctx.dtype)
    return _rms(x, final_norm_g).astype(x.dtype)
```

```cpp
#include <hip/hip_runtime.h>
#include <hip/hip_cooperative_groups.h>
#include <cstdio>
namespace cg = cooperative_groups;

#define LAS __attribute__((address_space(3)))
typedef _Float16 f16;
typedef _Float16 h8 __attribute__((ext_vector_type(8)));
typedef _Float16 h4 __attribute__((ext_vector_type(4)));
typedef _Float16 h2 __attribute__((ext_vector_type(2)));
typedef float f32x4 __attribute__((ext_vector_type(4)));

constexpr int DM = 1024, EI = 2048, TL = 2048, TC = 256, TS = 2304, HBN = 4, MH = HBN * TS;
constexpr size_t MiB = 1u << 20;
constexpr size_t SLOT = 36 * MiB;
constexpr size_t WS_WIN1T = 0, WS_WCO = 8 * MiB, WS_WOUT1T = 12 * MiB, WS_X1C = 16 * MiB, WS_SEGT = 24 * MiB,
                 WS_MODS = 29 * MiB, WS_LB0 = 29 * MiB + 512 * 1024, WS_COEF = 29 * MiB + 768 * 1024, WS_DYN = 30 * MiB;
constexpr size_t WS_WIN0T = WS_DYN, WS_WOUT0T = WS_DYN + 20 * MiB, WS_H = WS_DYN + 24 * MiB, WS_R = WS_DYN + 42 * MiB;
constexpr size_t WS_S = WS_DYN;
constexpr int LDS_BYTES = 131072;

struct Params {
    const float *x, *c, *ctx, *c_ctx, *ada_w, *ada_b, *norm_g, *final_g, *hg_w_in, *hg_lb, *hg_norm_g, *hg_w_out,
                *rg_w_in, *rg_conv_w, *rg_conv_b, *rg_w_a, *rg_b_a, *rg_w_x, *rg_b_x, *rg_lambda, *rg_w_out;
    float* out; unsigned char* ws;
};

__device__ __forceinline__ int otid() { int t = threadIdx.x; asm volatile("" : "+v"(t)); return t; }
__device__ __forceinline__ float sigm(float v) { return 1.f / (1.f + __expf(-v)); }
__device__ __forceinline__ float silu(float v) { return v * sigm(v); }
__device__ __forceinline__ float shx(float v, int lane, int o) { return __int_as_float(__builtin_amdgcn_ds_bpermute((lane ^ o) << 2, __float_as_int(v))); }
__device__ __forceinline__ float wave_sum(float v, int lane) {
#pragma unroll
    for (int o = 32; o > 0; o >>= 1) v += shx(v, lane, o);
    return v;
}

namespace pg8 {
constexpr int BM = 256, BK = 64, HALF = 128, HTB = HALF * BK * 2, STAGE_BYTES = 8 * HTB, NXCD = 8, WGM = 8;
__device__ __forceinline__ int lds_byte(int r, int c) { const int st = (r >> 4) * 2 + (c >> 5), rr = r & 15, cc = c & 31, ob = rr * 64 + cc * 2; return st * 1024 + (ob ^ (((ob >> 9) & 1) << 5)); }
__device__ __forceinline__ void stage_rc(int b, int& R, int& C) { const int st = b / 1024, sb = b % 1024, swz = sb ^ (((sb >> 9) & 1) << 5); R = (st >> 1) * 16 + swz / 64; C = (st & 1) * 32 + (swz % 64) / 2; }
__device__ __forceinline__ int perm32(int rho) { const int n = rho >> 4, i = rho & 15; return 8 * (i >> 2) + 4 * n + (i & 3); }

struct Unit { int pm, pn; };
struct Gemm { const f16* A; const f16* Bt; int nM, nN, K, lda, ldb, mode; };

struct StaticOrder {
    int nM, nN, nwg, G, c, mode;
    __device__ void init(int nM_, int nN_, int G_, int c_, int mode_) { nM = nM_; nN = nN_; nwg = nM * nN; G = G_; c = c_; mode = mode_; }
    __device__ bool next(int i, Unit& u) const {
        const long L = (long)i * G + c; if (L >= nwg) return false;
        int wgid = (int)L; { const int q = nwg / NXCD, r = nwg % NXCD, xcd = wgid % NXCD, off = wgid / NXCD; wgid = (xcd < r ? xcd * (q + 1) : r * (q + 1) + (xcd - r) * q) + off; }
        const int nig = WGM * nN, gid = wgid / nig, fm = gid * WGM, gsz = (nM - fm) < WGM ? (nM - fm) : WGM;
        int pm = fm + ((wgid % nig) % gsz); u.pn = (wgid % nig) / gsz;
        if (mode == 1) pm = (pm >> 3) * 9 + 1 + (pm & 7);
        u.pm = pm; return true;
    }
};

template <class Epi>
__device__ __forceinline__ void gemm_phase(LAS unsigned char* lds, const Gemm g, const StaticOrder& S, const Epi& E) {
    const int tid = otid(), wid = __builtin_amdgcn_readfirstlane(tid >> 6), lane = tid & 63, wr = wid >> 2, wc = wid & 3, fr = lane & 15, fq = lane >> 4;
    const int K = g.K, nt = K / BK;
    unsigned voffA[2], voffB[2];
#pragma unroll
    for (int i = 0; i < 2; ++i) { int R, C; stage_rc(tid * 16 + i * 8192, R, C); const int Rb = (R & ~31) + perm32(R & 31);
        voffA[i] = (unsigned)(R * g.lda + C) * 2u; voffB[i] = (unsigned)(Rb * g.ldb + C) * 2u; }
    const size_t kstep = (size_t)(BK * 2);
    const size_t hstepA = (size_t)HALF * g.lda * 2, hstepB = (size_t)HALF * g.ldb * 2;
    const unsigned ldsw = (unsigned)wid * 1024u;
    const int aoff = lds_byte(wr * 64 + fr, fq * 8), boff = lds_byte(wc * 32 + fr, fq * 8);
#define PG8_SA(b, h) (((b) * 2 + (h)) * HTB)
#define PG8_SB(b, h) ((4 + (b) * 2 + (h)) * HTB)
#define PG8_STAGE(bufoff, gbase, voff) do { const char* _gb = (const char*)(gbase); asm volatile("" : "+s"(_gb)); _Pragma("unroll") for (int _i = 0; _i < 2; ++_i) \
        __builtin_amdgcn_global_load_lds((const unsigned*)(_gb + (voff)[_i]), (LAS unsigned*)(lds + (bufoff) + ldsw + _i * 8192), 16, 0, 0); } while (0)
#define PG8_LDA(dst, b, h) do { _Pragma("unroll") for (int m = 0; m < 4; ++m) _Pragma("unroll") for (int k = 0; k < 2; ++k) dst[m][k] = *(const LAS h8*)(lds + PG8_SA(b, h) + aoff + m * 2048 + k * 1024); } while (0)
#define PG8_LDB(dst, b, h) do { _Pragma("unroll") for (int n = 0; n < 2; ++n) _Pragma("unroll") for (int k = 0; k < 2; ++k) dst[n][k] = *(const LAS h8*)(lds + PG8_SB(b, h) + boff + n * 2048 + k * 1024); } while (0)
#define PG8_MMA(ai, bj, At, Bt) do { __builtin_amdgcn_s_setprio(1); _Pragma("unroll") for (int m = 0; m < 4; ++m) _Pragma("unroll") for (int n = 0; n < 2; ++n) _Pragma("unroll") for (int k = 0; k < 2; ++k) \
        acc[ai][bj][m][n] = __builtin_amdgcn_mfma_f32_16x16x32_f16(Bt[n][k], At[m][k], acc[ai][bj][m][n], 0, 0, 0); __builtin_amdgcn_s_setprio(0); } while (0)
#define PG8_WAIT_V(n) asm volatile("s_waitcnt vmcnt(" #n ")" ::: "memory")
#define PG8_WAIT_L(n) asm volatile("s_waitcnt lgkmcnt(" #n ")" ::: "memory")
#define PG8_BAR __builtin_amdgcn_s_barrier()
#define PG8_SCHED __builtin_amdgcn_sched_barrier(0)
#define PG8_UA(u) ((const char*)g.A + ((size_t)(u).pm * BM * g.lda + (g.mode == 2 ? (size_t)((((u).pn & 15) >> 1) * 256) : (size_t)0)) * 2)
#define PG8_UB(u) ((const char*)g.Bt + (size_t)(u).pn * BM * g.ldb * 2)
    Unit cur, nxt; int ui = 0;
    if (!S.next(0, cur)) return;
    f32x4 acc[2][2][4][2];
#pragma unroll
    for (int a = 0; a < 2; ++a)
#pragma unroll
        for (int b = 0; b < 2; ++b)
#pragma unroll
            for (int m = 0; m < 4; ++m)
#pragma unroll
                for (int n = 0; n < 2; ++n) acc[a][b][m][n] = (f32x4){0.f, 0.f, 0.f, 0.f};
    h8 At[4][2], B0[2][2], B1[2][2];
    const char* cA = PG8_UA(cur); const char* cB = PG8_UB(cur);
    PG8_STAGE(PG8_SB(0, 0), cB, voffB); PG8_STAGE(PG8_SB(0, 1), cB + hstepB, voffB); PG8_STAGE(PG8_SA(0, 0), cA, voffA); PG8_STAGE(PG8_SA(0, 1), cA + hstepA, voffA);
    if (wr == 1) PG8_BAR;
    PG8_WAIT_V(2); PG8_BAR;
    PG8_STAGE(PG8_SB(1, 0), cB + kstep, voffB); PG8_STAGE(PG8_SA(1, 0), cA + kstep, voffA); PG8_STAGE(PG8_SB(1, 1), cB + hstepB + kstep, voffB);
    PG8_WAIT_V(6); PG8_BAR;
    for (;;) {
        const bool has_next = S.next(ui + 1, nxt);
        const char* nA = has_next ? PG8_UA(nxt) : cA; const char* nB = has_next ? PG8_UB(nxt) : cB;
        for (int t = 0; t < nt; t += 2) {
            const bool last = (t == nt - 2);
            const char* a1 = cA + (size_t)(t + 1) * kstep;
            const char* a2 = last ? nA : cA + (size_t)(t + 2) * kstep; const char* b2 = last ? nB : cB + (size_t)(t + 2) * kstep;
            const char* a3 = a2 + kstep; const char* b3 = b2 + kstep;
            PG8_LDB(B0, 0, 0); PG8_LDB(B1, 0, 1); PG8_SCHED; PG8_LDA(At, 0, 0); PG8_STAGE(PG8_SA(1, 1), a1 + hstepA, voffA);
            PG8_WAIT_V(8); PG8_WAIT_L(0); PG8_BAR; PG8_MMA(0, 0, At, B0); PG8_MMA(0, 1, At, B1); PG8_BAR; PG8_SCHED;
            PG8_LDA(At, 0, 1); PG8_STAGE(PG8_SB(0, 0), b2, voffB); PG8_STAGE(PG8_SB(0, 1), b2 + hstepB, voffB); PG8_STAGE(PG8_SA(0, 0), a2, voffA);
            PG8_WAIT_V(8); PG8_WAIT_L(0); PG8_BAR; PG8_MMA(1, 0, At, B0); PG8_MMA(1, 1, At, B1); PG8_BAR; PG8_SCHED;
            PG8_LDB(B0, 1, 0); PG8_LDB(B1, 1, 1); PG8_SCHED; PG8_LDA(At, 1, 0); PG8_STAGE(PG8_SA(0, 1), a2 + hstepA, voffA);
            PG8_WAIT_V(8); PG8_WAIT_L(0); PG8_BAR; PG8_MMA(0, 0, At, B0); PG8_MMA(0, 1, At, B1); PG8_BAR; PG8_SCHED;
            PG8_LDA(At, 1, 1); PG8_STAGE(PG8_SB(1, 0), b3, voffB); PG8_STAGE(PG8_SB(1, 1), b3 + hstepB, voffB); PG8_STAGE(PG8_SA(1, 0), a3, voffA);
            PG8_WAIT_V(8); PG8_WAIT_L(0); PG8_BAR; PG8_MMA(1, 0, At, B0); PG8_MMA(1, 1, At, B1); PG8_BAR; PG8_SCHED;
        }
        if (wr == 0) PG8_BAR;
        E(acc, cur, wr, wc, fr, fq);
        if (!has_next) break;
#pragma unroll
        for (int a = 0; a < 2; ++a)
#pragma unroll
            for (int b = 0; b < 2; ++b)
#pragma unroll
                for (int m = 0; m < 4; ++m)
#pragma unroll
                    for (int n = 0; n < 2; ++n) acc[a][b][m][n] = (f32x4){0.f, 0.f, 0.f, 0.f};
        cur = nxt; cA = nA; cB = nB; ++ui;
        if (wr == 1) PG8_BAR;
    }
    PG8_WAIT_V(0);
    PG8_BAR;
#undef PG8_SA
#undef PG8_SB
#undef PG8_STAGE
#undef PG8_LDA
#undef PG8_LDB
#undef PG8_MMA
#undef PG8_UA
#undef PG8_UB
}

__device__ __forceinline__ h8 pack8(const float (&v)[8]) { h8 r;
#pragma unroll
    for (int i = 0; i < 8; ++i) r[i] = (f16)v[i];
    return r; }

struct Epi1 {
    static constexpr bool PERM = true;
    f16* R; const float* lb;
    __device__ __forceinline__ void operator()(const f32x4 (&acc)[2][2][4][2], const Unit& u, int wr, int wc, int fr, int fq) const {
        asm volatile("" : "+v"(fr), "+v"(fq));
        const int t = u.pn >> 3; f16* dst = R + (size_t)t * (SLOT / 2);
        const int row0 = u.pm * BM + wr * 64 + fr, col0 = (u.pn & 7) * 256 + wc * 32 + fq * 8;
        float lbv[2][8];
        if (t == 2 || t == 3) {
#pragma unroll
            for (int bj = 0; bj < 2; ++bj)
#pragma unroll
                for (int i = 0; i < 8; ++i) lbv[bj][i] = lb[col0 + bj * HALF + i];
        }
#pragma unroll
        for (int ai = 0; ai < 2; ++ai)
#pragma unroll
            for (int m = 0; m < 4; ++m) {
                f16* rowp = dst + (size_t)(row0 + ai * HALF + m * 16) * EI + col0;
#pragma unroll
                for (int bj = 0; bj < 2; ++bj) {
                    float v[8];
#pragma unroll
                    for (int n = 0; n < 2; ++n)
#pragma unroll
                        for (int i = 0; i < 4; ++i) v[n * 4 + i] = acc[ai][bj][m][n][i];
                    if (t == 0 || t == 4) {
#pragma unroll
                        for (int i = 0; i < 8; ++i) v[i] = silu(v[i]);
                    } else if (t == 2 || t == 3) {
#pragma unroll
                        for (int i = 0; i < 8; ++i) { const float l = lbv[bj][i]; v[i] = __logf(l + (1.f - l) * sigm(v[i])); }
                    }
                    *(h8*)(rowp + bj * HALF) = pack8(v);
                }
                asm volatile("" ::: "memory"); __builtin_amdgcn_sched_barrier(0);
            }
    }
};

struct Epi2 {
    static constexpr bool PERM = true;
    const float* x; const float* ctx; float* out; float* x1c; const float* mods; int hb;
    __device__ __forceinline__ void operator()(const f32x4 (&acc)[2][2][4][2], const Unit& u, int wr, int wc, int fr, int fq) const {
        asm volatile("" : "+v"(fr), "+v"(fq));
        const int bl = u.pm / 9, tib = u.pm % 9, b = hb * HBN + bl;
        const bool isctx = (tib == 0);
        const float* gp = mods + (size_t)(isctx ? 8 : b) * 3072 + 2048;
        const int col0 = u.pn * BM + wc * 32 + fq * 8;
        f32x4 gv[2][2];
#pragma unroll
        for (int bj = 0; bj < 2; ++bj)
#pragma unroll
            for (int n = 0; n < 2; ++n) gv[bj][n] = *(const f32x4*)(gp + col0 + bj * HALF + n * 4);
#pragma unroll
        for (int ai = 0; ai < 2; ++ai)
#pragma unroll
            for (int m = 0; m < 4; ++m) {
                const int s = tib * 256 + ai * HALF + wr * 64 + m * 16 + fr;
                const float* src; float* dst;
                if (isctx) { const size_t o = ((size_t)b * TC + s) * DM; src = ctx + o; dst = x1c + o; }
                else { const size_t o = ((size_t)b * TL + (s - TC)) * DM; src = x + o; dst = out + o; }
#pragma unroll
                for (int bj = 0; bj < 2; ++bj)
#pragma unroll
                    for (int n = 0; n < 2; ++n) {
                        const int c = col0 + bj * HALF + n * 4;
                        const f32x4 xv = *(const f32x4*)(src + c);
                        *(f32x4*)(dst + c) = xv + gv[bj][n] * acc[ai][bj][m][n];
                    }
                asm volatile("" ::: "memory"); __builtin_amdgcn_sched_barrier(0);
            }
    }
};

struct Epi3 {
    static constexpr bool PERM = true;
    f16* S;
    __device__ __forceinline__ void operator()(const f32x4 (&acc)[2][2][4][2], const Unit& u, int wr, int wc, int fr, int fq) const {
        asm volatile("" : "+v"(fr), "+v"(fq));
        const int t = u.pn >> 3; f16* dst = S + (size_t)t * (SLOT / 2);
        const int row0 = u.pm * BM + wr * 64 + fr, col0 = (u.pn & 7) * 256 + wc * 32 + fq * 8;
#pragma unroll
        for (int ai = 0; ai < 2; ++ai)
#pragma unroll
            for (int m = 0; m < 4; ++m) {
                f16* rowp = dst + (size_t)(row0 + ai * HALF + m * 16) * EI + col0;
#pragma unroll
                for (int bj = 0; bj < 2; ++bj) {
                    float v[8];
#pragma unroll
                    for (int n = 0; n < 2; ++n)
#pragma unroll
                        for (int i = 0; i < 4; ++i) v[n * 4 + i] = acc[ai][bj][m][n][i];
                    if (t == 1) {
#pragma unroll
                        for (int i = 0; i < 8; ++i) v[i] = silu(v[i]);
                    }
                    *(h8*)(rowp + bj * HALF) = pack8(v);
                }
                asm volatile("" ::: "memory"); __builtin_amdgcn_sched_barrier(0);
            }
    }
};

struct Epi4 {
    static constexpr bool PERM = true;
    const f16* XC; f16* S; const f32x4* coef;
    __device__ __forceinline__ void operator()(const f32x4 (&acc)[2][2][4][2], const Unit& u, int wr, int wc, int fr, int fq) const {
        asm volatile("" : "+v"(fr), "+v"(fq));
        const int d = u.pn >> 4, gi = u.pn & 15;
        const int ch0 = gi * 128 + wc * 32 + fq * 8;
        f16* LA = S + (size_t)(d ? 0 : 3) * (SLOT / 2); f16* U = S + (size_t)(d ? 5 : 4) * (SLOT / 2);
        const f32x4* cf = coef + d * EI + ch0;
        const int row0 = u.pm * BM + wr * 64 + fr;
#pragma unroll
        for (int ai = 0; ai < 2; ++ai)
#pragma unroll
            for (int m = 0; m < 4; ++m) {
                const size_t o = (size_t)(row0 + ai * HALF + m * 16) * EI + ch0;
                const h8 xc = *(const h8*)(XC + o);
                float la[8], uu[8];
#pragma unroll
                for (int n = 0; n < 2; ++n)
#pragma unroll
                    for (int i = 0; i < 4; ++i) {
                        const int j = n * 4 + i;
                        const f32x4 cc = cf[j];
                        const float r = sigm(acc[ai][0][m][n][i] + cc[0]), ig = sigm(acc[ai][1][m][n][i] + cc[1]);
                        const float l = r * cc[2], y = 2.f * l;
                        const float poly = -y * (1.f + y * (0.5f + y * (0.16666667f + y * (0.041666668f + y * (0.0083333338f + y * 0.0013888889f)))));
                        const float om = (y > -0.25f) ? poly : 1.f - __expf(y);
                        la[j] = l * 256.f;
                        uu[j] = sqrtf(om) * ig * (float)xc[j];
                    }
                *(h8*)(LA + o) = pack8(la);
                *(h8*)(U + o) = pack8(uu);
                asm volatile("" ::: "memory"); __builtin_amdgcn_sched_barrier(0);
            }
    }
};

struct Epi5 {
    static constexpr bool PERM = true;
    float* out; const float* mods; int hb;
    __device__ __forceinline__ void operator()(const f32x4 (&acc)[2][2][4][2], const Unit& u, int wr, int wc, int fr, int fq) const {
        asm volatile("" : "+v"(fr), "+v"(fq));
        const int bl = u.pm / 9, tib = u.pm % 9, b = hb * HBN + bl;
        const float* gp = mods + (size_t)b * 3072 + 2048;
        const int col0 = u.pn * BM + wc * 32 + fq * 8;
        f32x4 gv[2][2];
#pragma unroll
        for (int bj = 0; bj < 2; ++bj)
#pragma unroll
            for (int n = 0; n < 2; ++n) gv[bj][n] = *(const f32x4*)(gp + col0 + bj * HALF + n * 4);
#pragma unroll
        for (int ai = 0; ai < 2; ++ai)
#pragma unroll
            for (int m = 0; m < 4; ++m) {
                const int p = (tib - 1) * 256 + ai * HALF + wr * 64 + m * 16 + fr;
                const int t = (p & 31) * 64 + (p >> 5);
                float* dst = out + ((size_t)b * TL + t) * DM;
#pragma unroll
                for (int bj = 0; bj < 2; ++bj)
#pragma unroll
                    for (int n = 0; n < 2; ++n) {
                        const int c = col0 + bj * HALF + n * 4;
                        const f32x4 xv = *(const f32x4*)(dst + c);
                        *(f32x4*)(dst + c) = xv + gv[bj][n] * acc[ai][bj][m][n];
                    }
                asm volatile("" ::: "memory"); __builtin_amdgcn_sched_barrier(0);
            }
    }
};
}

__device__ void tr_tile(const float* src, int lds_n, f16* dst, int ldd, int k0, int n0, float* tile) {
    const int tid = otid();
    __syncthreads();
#pragma unroll
    for (int i = 0; i < 8; ++i) { const int idx = tid + i * 512, kk = idx >> 6, nn = idx & 63; tile[kk * 65 + nn] = src[(size_t)(k0 + kk) * lds_n + n0 + nn]; }
    __syncthreads();
#pragma unroll
    for (int i = 0; i < 4; ++i) { const int idx = tid + i * 512, nn = idx >> 5, kp = idx & 31;
        h2 v; v[0] = (f16)tile[(2 * kp) * 65 + nn]; v[1] = (f16)tile[(2 * kp + 1) * 65 + nn];
        *(h2*)(dst + (size_t)(n0 + nn) * ldd + k0 + 2 * kp) = v; }
}

__device__ void phase0(const Params& p, unsigned char* lds) {
    const int tid = otid(), G = gridDim.x;
    float* mods = (float*)(p.ws + WS_MODS);
    { const int idx = blockIdx.x * 512 + tid;
      if (idx < EI) { const float a = p.hg_lb[idx], b = p.hg_lb[EI + idx], c = p.hg_lb[2 * EI + idx]; const float m = fmaxf(a, fmaxf(b, c));
          const float ea = __expf(a - m), eb = __expf(b - m), ec = __expf(c - m); ((float*)(p.ws + WS_LB0))[idx] = ea / (ea + eb + ec); } }
    { const int idx = blockIdx.x * 512 + tid;
      if (idx < 2 * EI) ((f32x4*)(p.ws + WS_COEF))[idx] = (f32x4){p.rg_b_a[idx], p.rg_b_x[idx], -8.f * log1pf(__expf(-p.rg_lambda[idx])), 0.f}; }
    float* sc = (float*)lds;
    float* red = sc + 9 * 1024;
    for (int item = blockIdx.x; item < 192; item += G) {
        const int l = item / 96, n0 = (item % 96) * 32;
        __syncthreads();
        for (int i = tid; i < 9 * 1024; i += 512) { const int j = i >> 10, k = i & 1023; const float v = (j < 8) ? p.c[j * 1024 + k] : p.c_ctx[k]; sc[i] = silu(v); }
        __syncthreads();
        const int col = tid & 31, ks = tid >> 5;
        float a[9];
#pragma unroll
        for (int j = 0; j < 9; ++j) a[j] = 0.f;
        const float* w = p.ada_w + (size_t)l * 1024 * 3072 + n0 + col;
#pragma unroll 8
        for (int k = ks * 64; k < ks * 64 + 64; ++k) { const float wv = w[(size_t)k * 3072];
#pragma unroll
            for (int j = 0; j < 9; ++j) a[j] += sc[j * 1024 + k] * wv; }
#pragma unroll
        for (int j = 0; j < 9; ++j) red[(ks * 9 + j) * 32 + col] = a[j];
        __syncthreads();
        if (tid < 288) { const int j = tid >> 5, cc = tid & 31; float s = p.ada_b[l * 3072 + n0 + cc];
            for (int q = 0; q < 16; ++q) s += red[(q * 9 + j) * 32 + cc];
            mods[(size_t)(l * 9 + j) * 3072 + n0 + cc] = s; }
    }
    float* tile = (float*)lds;
    f16* win0t = (f16*)(p.ws + WS_WIN0T); f16* wout0t = (f16*)(p.ws + WS_WOUT0T); f16* win1t = (f16*)(p.ws + WS_WIN1T);
    f16* wout1t = (f16*)(p.ws + WS_WOUT1T); f16* wco = (f16*)(p.ws + WS_WCO);
    for (int job = blockIdx.x; job < 5120; job += G) {
        if (job < 2560) { const int kt = job / 160, ntl = job % 160; tr_tile(p.hg_w_in, 10240, win0t, 1024, kt * 64, ntl * 64, tile); }
        else if (job < 3072) { const int j = job - 2560, kt = j / 16, ntl = j % 16; tr_tile(p.hg_w_out, 1024, wout0t, 2048, kt * 64, ntl * 64, tile); }
        else if (job < 4096) { const int j = job - 3072, kt = j / 64, ntl = j % 64; tr_tile(p.rg_w_in, 4096, win1t, 1024, kt * 64, ntl * 64, tile); }
        else if (job < 4608) { const int j = job - 4096, kt = j / 16, ntl = j % 16; tr_tile(p.rg_w_out, 1024, wout1t, 2048, kt * 64, ntl * 64, tile); }
        else { const int j = job - 4608, mat = j / 16, tl = j % 16, kt = tl / 4, ntl = tl % 4;
            const int hh = mat & 7, which = (mat >> 3) & 1, d = mat >> 4;
            const float* src = (which ? p.rg_w_x : p.rg_w_a) + (size_t)(d * 8 + hh) * 256 * 256;
            const int n0 = ntl * 64;
            f16* dst = wco + (size_t)((d * 16 + hh * 2 + (n0 >> 7)) * 256 + which * 128 + (n0 & 127)) * 256;
            tr_tile(src, 256, dst - (size_t)n0 * 256, 256, kt * 64, n0, tile); }
    }
}

template <int LAYER>
__device__ void phase_h(const Params& p, int hb) {
    const int tid_ = otid(), lane = tid_ & 63, wid = tid_ >> 6;
    const float* mods = (const float*)(p.ws + WS_MODS) + (size_t)LAYER * 9 * 3072;
    const float* g = p.norm_g + LAYER * DM;
    f16* H = (f16*)(p.ws + (LAYER == 0 ? WS_H : WS_S + 5 * SLOT));
    const float* x1c = (const float*)(p.ws + WS_X1C);
    for (int r = blockIdx.x * 8 + wid; r < MH; r += gridDim.x * 8) {
        const int bl = r / TS, s = r % TS, b = hb * HBN + bl;
        const float* src; int j;
        if (s < TC) { j = 8; src = (LAYER == 0 ? p.ctx : x1c) + ((size_t)b * TC + s) * DM; }
        else { j = b; const int q = s - TC; const int t = (LAYER == 0) ? q : ((q & 31) * 64 + (q >> 5));
               src = (LAYER == 0 ? p.x : (const float*)p.out) + ((size_t)b * TL + t) * DM; }
        const float* md = mods + (size_t)j * 3072;
        f32x4 v[4]; float ss = 0.f;
#pragma unroll
        for (int i = 0; i < 4; ++i) { v[i] = *(const f32x4*)(src + lane * 4 + i * 256); ss += v[i][0] * v[i][0] + v[i][1] * v[i][1] + v[i][2] * v[i][2] + v[i][3] * v[i][3]; }
        ss = wave_sum(ss, lane);
        const float rs = rsqrtf(ss * (1.f / DM) + 1e-6f);
#pragma unroll
        for (int i = 0; i < 4; ++i) { const int k = lane * 4 + i * 256;
            const f32x4 gg = *(const f32x4*)(g + k), sh = *(const f32x4*)(md + k), scl = *(const f32x4*)(md + 1024 + k);
            h4 o;
#pragma unroll
            for (int e = 0; e < 4; ++e) o[e] = (f16)(v[i][e] * rs * gg[e] * (1.f + scl[e]) + sh[e]);
            *(h4*)(H + (size_t)r * DM + k) = o; }
    }
}

__device__ void phase_hgrn(const Params& p, unsigned char* lds) {
    const int tid = otid(), lane = tid & 63, w = tid >> 6, v16 = lane & 15, kq = lane >> 4;
    float* Fs = (float*)lds; float* Qs = Fs + 64 * 128; float* Vs = Qs + 64 * 128; f16* Os = (f16*)(Vs + 64 * 128);
    const f16* Q = (const f16*)(p.ws + WS_R); const f16* V = Q + SLOT / 2;
    for (int chain = blockIdx.x; chain < 128; chain += gridDim.x) {
        const int dir = chain & 1, h = (chain >> 1) & 15, bl = chain >> 5;
        f16* LF = (f16*)(p.ws + WS_R) + (size_t)(2 + dir) * (SLOT / 2);
        float S[32];
#pragma unroll
        for (int i = 0; i < 32; ++i) S[i] = 0.f;
        for (int cc = 0; cc < 36; ++cc) {
            const int cpos = dir ? (cc < 4 ? 3 - cc : 39 - cc) : cc;
            const size_t base = ((size_t)bl * TS + cpos * 64) * EI + h * 128;
            __syncthreads();
            { const int row = tid >> 3, c16 = (tid & 7) * 16; const size_t o = base + (size_t)row * EI + c16;
#pragma unroll
              for (int hh = 0; hh < 2; ++hh) { const h8 qv = *(const h8*)(Q + o + hh * 8), vv = *(const h8*)(V + o + hh * 8), lv = *(const h8*)(LF + o + hh * 8);
#pragma unroll
                  for (int e = 0; e < 8; ++e) { const int li = row * 128 + c16 + hh * 8 + e; Qs[li] = (float)qv[e]; Vs[li] = (float)vv[e]; Fs[li] = __expf((float)lv[e]); } } }
            __syncthreads();
            for (int i = 0; i < 64; ++i) {
                const int tt = dir ? 63 - i : i;
                const float vv = Vs[tt * 128 + w * 16 + v16];
                const f32x4* fp = (const f32x4*)(Fs + tt * 128 + kq * 32); const f32x4* qp = (const f32x4*)(Qs + tt * 128 + kq * 32);
                float o = 0.f;
#pragma unroll
                for (int k4 = 0; k4 < 8; ++k4) { const f32x4 f = fp[k4], q = qp[k4];
#pragma unroll
                    for (int e = 0; e < 4; ++e) { float s = S[k4 * 4 + e]; s = f[e] * (s - vv) + vv; S[k4 * 4 + e] = s; o += s * q[e]; } }
                o += shx(o, lane, 16); o += shx(o, lane, 32);
                if (kq == 0) Os[tt * 128 + w * 16 + v16] = (f16)o;
            }
            __syncthreads();
            { const int row = tid >> 3, c16 = (tid & 7) * 16; const size_t o = base + (size_t)row * EI + c16;
              *(h8*)(LF + o) = *(const h8*)(Os + row * 128 + c16); *(h8*)(LF + o + 8) = *(const h8*)(Os + row * 128 + c16 + 8); }
        }
    }
}

__device__ void phase_readout(const Params& p) {
    const int tid_ = otid(), lane = tid_ & 63, wid = tid_ >> 6;
    f16* OF = (f16*)(p.ws + WS_R) + (size_t)2 * (SLOT / 2); const f16* OB = OF + SLOT / 2; const f16* Gt = OB + SLOT / 2;
    for (int r = blockIdx.x * 8 + wid; r < MH; r += gridDim.x * 8) {
        const size_t o = (size_t)r * EI + lane * 32;
        float v[32]; float ss = 0.f;
#pragma unroll
        for (int q = 0; q < 4; ++q) { const h8 a = *(const h8*)(OF + o + q * 8), b = *(const h8*)(OB + o + q * 8);
#pragma unroll
            for (int e = 0; e < 8; ++e) { const float s = (float)a[e] + (float)b[e]; v[q * 8 + e] = s; ss += s * s; } }
        ss += shx(ss, lane, 1); ss += shx(ss, lane, 2);
        const float rs = rsqrtf(ss * (1.f / 128.f) + 1e-6f);
#pragma unroll
        for (int q = 0; q < 4; ++q) { const h8 gt = *(const h8*)(Gt + o + q * 8); float ov[8];
#pragma unroll
            for (int e = 0; e < 8; ++e) ov[e] = v[q * 8 + e] * rs * p.hg_norm_g[lane * 32 + q * 8 + e] * (float)gt[e];
            *(h8*)(OF + o + q * 8) = pg8::pack8(ov); }
    }
}

__device__ void phase_conv(const Params& p) {
    const f16* XB = (const f16*)(p.ws + WS_S); f16* XC = (f16*)(p.ws + WS_S) + (size_t)2 * (SLOT / 2);
    const int tid_ = otid();
    for (int idx = blockIdx.x * 512 + tid_; idx < MH * 256; idx += gridDim.x * 512) {
        const int r = idx >> 8, ch = (idx & 255) * 8, s = r % TS;
        const int lo = (s < TC) ? 0 : TC, hi = (s < TC) ? TC : TS;
        float a[8];
#pragma unroll
        for (int e = 0; e < 8; ++e) a[e] = p.rg_conv_b[ch + e];
#pragma unroll
        for (int j = 0; j < 4; ++j) { const int ss = s - 2 + j;
            if (ss >= lo && ss < hi) { const h8 xv = *(const h8*)(XB + (size_t)(r - 2 + j) * EI + ch);
#pragma unroll
                for (int e = 0; e < 8; ++e) a[e] += p.rg_conv_w[j * EI + ch + e] * (float)xv[e]; } }
        *(h8*)(XC + (size_t)r * EI + ch) = pg8::pack8(a);
    }
}

__device__ void phase_scan_local(const Params& p) {
    f16* Sb = (f16*)(p.ws + WS_S); f32x4* segt = (f32x4*)(p.ws + WS_SEGT);
    const int tid_ = otid();
    for (int idx = blockIdx.x * 512 + tid_; idx < HBN * 2 * 36 * 1024; idx += gridDim.x * 512) {
        const int cp = idx & 1023, seg = (idx >> 10) % 36, dir = (idx / 36864) & 1, bl = idx / 73728;
        f16* LA = Sb + (size_t)(dir ? 0 : 3) * (SLOT / 2); f16* U = Sb + (size_t)(dir ? 5 : 4) * (SLOT / 2);
        const size_t base = ((size_t)bl * TS + seg * 64) * EI + cp * 2;
        float h0 = 0.f, h1 = 0.f, L0 = 0.f, L1 = 0.f;
#pragma unroll 8
        for (int i = 0; i < 64; ++i) {
            const int tt = dir ? 63 - i : i; const size_t o = base + (size_t)tt * EI;
            const h2 la = *(const h2*)(LA + o), u = *(const h2*)(U + o);
            const float l0 = (float)la[0] * (1.f / 256.f), l1 = (float)la[1] * (1.f / 256.f);
            h0 = __expf(l0) * h0 + (float)u[0]; h1 = __expf(l1) * h1 + (float)u[1]; L0 += l0; L1 += l1;
            h2 ho, lo; ho[0] = (f16)h0; ho[1] = (f16)h1; lo[0] = (f16)L0; lo[1] = (f16)L1;
            *(h2*)(U + o) = ho; *(h2*)(LA + o) = lo;
        }
        segt[(size_t)((bl * 2 + dir) * 36 + seg) * 1024 + cp] = (f32x4){L0, h0, L1, h1};
    }
}

__device__ void phase_scan_final(const Params& p) {
    f16* Sb = (f16*)(p.ws + WS_S); const f32x4* segt = (const f32x4*)(p.ws + WS_SEGT);
    const f16* LAf = Sb + (size_t)3 * (SLOT / 2); const f16* Uf = Sb + (size_t)4 * (SLOT / 2); const f16* LAb = Sb; const f16* Ub = Sb + (size_t)5 * (SLOT / 2);
    f16* G1 = Sb + (size_t)1 * (SLOT / 2);
    const int tid_ = otid();
    for (int idx = blockIdx.x * 512 + tid_; idx < HBN * 32 * 1024; idx += gridDim.x * 512) {
        const int cp = idx & 1023, seg = 4 + ((idx >> 10) & 31), bl = idx >> 15;
        float cf0 = 0.f, cf1 = 0.f, cb0 = 0.f, cb1 = 0.f;
        const f32x4* sf = segt + (size_t)((bl * 2 + 0) * 36) * 1024 + cp; const f32x4* sb = segt + (size_t)((bl * 2 + 1) * 36) * 1024 + cp;
        for (int sg = 0; sg < seg; ++sg) { const f32x4 t = sf[(size_t)sg * 1024]; cf0 = __expf(t[0]) * cf0 + t[1]; cf1 = __expf(t[2]) * cf1 + t[3]; }
        for (int sg = 3; sg >= 0; --sg) { const f32x4 t = sb[(size_t)sg * 1024]; cb0 = __expf(t[0]) * cb0 + t[1]; cb1 = __expf(t[2]) * cb1 + t[3]; }
        for (int sg = 35; sg > seg; --sg) { const f32x4 t = sb[(size_t)sg * 1024]; cb0 = __expf(t[0]) * cb0 + t[1]; cb1 = __expf(t[2]) * cb1 + t[3]; }
        const size_t base = ((size_t)bl * TS + seg * 64) * EI + cp * 2;
#pragma unroll 8
        for (int i = 0; i < 64; ++i) { const size_t o = base + (size_t)i * EI;
            const h2 lf = *(const h2*)(LAf + o), uf = *(const h2*)(Uf + o), lb = *(const h2*)(LAb + o), ub = *(const h2*)(Ub + o), g = *(const h2*)(G1 + o);
            const float y0 = (float)uf[0] + __expf((float)lf[0]) * cf0 + (float)ub[0] + __expf((float)lb[0]) * cb0;
            const float y1 = (float)uf[1] + __expf((float)lf[1]) * cf1 + (float)ub[1] + __expf((float)lb[1]) * cb1;
            h2 ov; ov[0] = (f16)(y0 * (float)g[0]); ov[1] = (f16)(y1 * (float)g[1]);
            *(h2*)(G1 + o) = ov; }
    }
}

__device__ void phase_final(const Params& p) {
    const int tid_ = otid(), lane = tid_ & 63, wid = tid_ >> 6;
    for (int r = blockIdx.x * 8 + wid; r < 8 * TL; r += gridDim.x * 8) {
        float* row = p.out + (size_t)r * DM;
        f32x4 v[4]; float ss = 0.f;
#pragma unroll
        for (int i = 0; i < 4; ++i) { v[i] = *(const f32x4*)(row + lane * 4 + i * 256); ss += v[i][0] * v[i][0] + v[i][1] * v[i][1] + v[i][2] * v[i][2] + v[i][3] * v[i][3]; }
        ss = wave_sum(ss, lane);
        const float rs = rsqrtf(ss * (1.f / DM) + 1e-6f);
#pragma unroll
        for (int i = 0; i < 4; ++i) { const int k = lane * 4 + i * 256; const f32x4 gg = *(const f32x4*)(p.final_g + k); *(f32x4*)(row + k) = v[i] * rs * gg; }
    }
}

__global__ void __launch_bounds__(512, 2) mega(Params p) {
    extern __shared__ __attribute__((aligned(16))) unsigned char lds_raw[];
    LAS unsigned char* lds = (LAS unsigned char*)lds_raw;
    cg::grid_group grid = cg::this_grid();
    const int G = gridDim.x, bid = blockIdx.x;
    unsigned char* ws = p.ws;

    phase0(p, lds_raw);
    grid.sync();

#pragma unroll 1
    for (int hb = 0; hb < 2; ++hb) {
        phase_h<0>(p, hb);
        grid.sync();
        { pg8::Gemm g{(const f16*)(ws + WS_H), (const f16*)(ws + WS_WIN0T), 36, 40, 1024, 1024, 1024, 0};
          pg8::StaticOrder S; S.init(36, 40, G, bid, 0);
          pg8::Epi1 E{(f16*)(ws + WS_R), (const float*)(ws + WS_LB0)};
          pg8::gemm_phase(lds, g, S, E); }
        grid.sync();
        phase_hgrn(p, lds_raw);
        grid.sync();
        phase_readout(p);
        grid.sync();
        { pg8::Gemm g{(const f16*)(ws + WS_R) + (size_t)2 * (SLOT / 2), (const f16*)(ws + WS_WOUT0T), 36, 4, 2048, 2048, 2048, 0};
          pg8::StaticOrder S; S.init(36, 4, G, bid, 0);
          pg8::Epi2 E{p.x, p.ctx, p.out, (float*)(ws + WS_X1C), (const float*)(ws + WS_MODS), hb};
          pg8::gemm_phase(lds, g, S, E); }
        grid.sync();
    }

#pragma unroll 1
    for (int hb = 0; hb < 2; ++hb) {
        phase_h<1>(p, hb);
        grid.sync();
        { pg8::Gemm g{(const f16*)(ws + WS_S + 5 * SLOT), (const f16*)(ws + WS_WIN1T), 36, 16, 1024, 1024, 1024, 0};
          pg8::StaticOrder S; S.init(36, 16, G, bid, 0);
          pg8::Epi3 E{(f16*)(ws + WS_S)};
          pg8::gemm_phase(lds, g, S, E); }
        grid.sync();
        phase_conv(p);
        grid.sync();
        { pg8::Gemm g{(const f16*)(ws + WS_S + 2 * SLOT), (const f16*)(ws + WS_WCO), 36, 32, 256, 2048, 256, 2};
          pg8::StaticOrder S; S.init(36, 32, G, bid, 0);
          pg8::Epi4 E{(const f16*)(ws + WS_S + 2 * SLOT), (f16*)(ws + WS_S), (const f32x4*)(ws + WS_COEF)};
          pg8::gemm_phase(lds, g, S, E); }
        grid.sync();
        phase_scan_local(p);
        grid.sync();
        phase_scan_final(p);
        grid.sync();
        { pg8::Gemm g{(const f16*)(ws + WS_S + 1 * SLOT), (const f16*)(ws + WS_WOUT1T), 32, 4, 2048, 2048, 2048, 1};
          pg8::StaticOrder S; S.init(32, 4, G, bid, 1);
          pg8::Epi5 E{p.out, (const float*)(ws + WS_MODS) + 9 * 3072, hb};
          pg8::gemm_phase(lds, g, S, E); }
        grid.sync();
    }
    phase_final(p);
}

extern "C" void kernel_launch(void* const* d_in, const int* in_sizes, int n_in, void* d_out, int out_size, void* d_ws, size_t ws_size, hipStream_t stream) {
    static int grid_blocks = 0;
    if (!grid_blocks) {
        int dev = 0, cus = 0, per_cu = 0;
        hipGetDevice(&dev);
        hipDeviceGetAttribute(&cus, hipDeviceAttributeMultiprocessorCount, dev);
        if (hipFuncSetAttribute((const void*)mega, hipFuncAttributeMaxDynamicSharedMemorySize, LDS_BYTES) != hipSuccess) fprintf(stderr, "hipFuncSetAttribute failed\n");
        hipOccupancyMaxActiveBlocksPerMultiprocessor(&per_cu, (const void*)mega, 512, LDS_BYTES);
        if (per_cu < 1) { fprintf(stderr, "occupancy query says %d blocks/CU\n", per_cu); per_cu = 1; }
        grid_blocks = cus;
        if (ws_size < 252 * MiB) fprintf(stderr, "workspace too small: %zu\n", ws_size);
    }
    Params p{};
    const float** pp = (const float**)&p;
    for (int i = 0; i < 21; ++i) pp[i] = (const float*)d_in[i];
    p.out = (float*)d_out; p.ws = (unsigned char*)d_ws;
    void* args[] = {&p};
    hipError_t e = hipLaunchCooperativeKernel((const void*)mega, dim3(grid_blocks), dim3(512), args, LDS_BYTES, stream);
    if (e != hipSuccess) fprintf(stderr, "cooperative launch failed: %s (grid %d)\n", hipGetErrorString(e), grid_blocks);
}
```

```cpp
#include <hip/hip_runtime.h>
#include <hip/hip_cooperative_groups.h>
#include <cstdio>
namespace cg = cooperative_groups;

#define LAS __attribute__((address_space(3)))
typedef _Float16 f16;
typedef _Float16 h8 __attribute__((ext_vector_type(8)));
typedef _Float16 h4 __attribute__((ext_vector_type(4)));
typedef _Float16 h2 __attribute__((ext_vector_type(2)));
typedef float f32x4 __attribute__((ext_vector_type(4)));

#define PROBE_ON 0
#define PROBE_DUR_MASK 0x0008u
#define PROBE_A_MASK   0x0C00u
#define PROBE_B_MASK   0x0001u
constexpr int DM = 1024, EI = 2048, TL = 2048, TC = 256, TS = 2304, HBN = 4, MH = HBN * TS;
constexpr size_t MiB = 1u << 20;
constexpr size_t SLOT = 36 * MiB;
constexpr size_t WS_WIN1T = 0, WS_WCO = 8 * MiB, WS_WOUT1T = 12 * MiB, WS_X1C = 16 * MiB, WS_SEGT = 24 * MiB,
                 WS_MODS = 29 * MiB, WS_LB0 = 29 * MiB + 512 * 1024, WS_COEF = 29 * MiB + 768 * 1024, WS_DYN = 30 * MiB;
constexpr size_t WS_WIN0T = WS_DYN, WS_WOUT0T = WS_DYN + 20 * MiB, WS_H = WS_DYN + 24 * MiB, WS_R = WS_DYN + 42 * MiB;
constexpr size_t WS_S = WS_DYN;
constexpr int LDS_XST = 159744;
constexpr int LDS_BYTES = LDS_XST + 64;
constexpr size_t WS_BAR = 29 * MiB + 928 * 1024;
constexpr size_t WS_TS = 29 * MiB + 900 * 1024;

struct Params {
    const float *x, *c, *ctx, *c_ctx, *ada_w, *ada_b, *norm_g, *final_g, *hg_w_in, *hg_lb, *hg_norm_g, *hg_w_out,
                *rg_w_in, *rg_conv_w, *rg_conv_b, *rg_w_a, *rg_b_a, *rg_w_x, *rg_b_x, *rg_lambda, *rg_w_out;
    float* out; unsigned char* ws;
};

__device__ __forceinline__ int otid(int wv_) { int l; asm volatile("v_mbcnt_lo_u32_b32 %0, -1, 0\n\tv_mbcnt_hi_u32_b32 %0, -1, %0" : "=v"(l)); return (wv_ << 6) | l; }
__device__ __forceinline__ const char* uni_ptr(const char* q) { const unsigned long long a = (unsigned long long)q; const unsigned lo = __builtin_amdgcn_readfirstlane((unsigned)a), hi = __builtin_amdgcn_readfirstlane((unsigned)(a >> 32)); return (const char*)(((unsigned long long)hi << 32) | lo); }
__device__ __forceinline__ float fexp(float v) { return __builtin_amdgcn_exp2f(v * 1.4426950408889634f); }
__device__ __forceinline__ float flog(float v) { return __builtin_amdgcn_logf(v) * 0.6931471805599453f; }
__device__ __forceinline__ float frcp(float v) { return __builtin_amdgcn_rcpf(v); }
__device__ __forceinline__ float fsqrt(float v) { return __builtin_amdgcn_sqrtf(v); }
__device__ __forceinline__ float sigm(float v) { return frcp(1.f + fexp(-v)); }
__device__ __forceinline__ float silu(float v) { return v * sigm(v); }
__device__ __forceinline__ float shx(float v, int lane, int o) { return __int_as_float(__builtin_amdgcn_ds_bpermute((lane ^ o) << 2, __float_as_int(v))); }
__device__ __forceinline__ float wave_sum(float v, int lane) {
#pragma unroll
    for (int o = 32; o > 0; o >>= 1) v += shx(v, lane, o);
    return v;
}

namespace pg8 {
constexpr int BM = 256, BK = 64, HALF = 128, HTB = HALF * BK * 2, STAGE_BYTES = 8 * HTB, NXCD = 8, WGM = 6;
__device__ __forceinline__ int lds_byte(int r, int c) { const int st = (r >> 4) * 2 + (c >> 5), rr = r & 15, cc = c & 31, ob = rr * 64 + cc * 2; return st * 1024 + (ob ^ (((ob >> 9) & 1) << 5)); }
__device__ __forceinline__ void stage_rc(int b, int& R, int& C) { const int st = b / 1024, sb = b % 1024, swz = sb ^ (((sb >> 9) & 1) << 5); R = (st >> 1) * 16 + swz / 64; C = (st & 1) * 32 + (swz % 64) / 2; }
__device__ __forceinline__ int perm32(int rho) { const int n = rho >> 4, i = rho & 15; return 8 * (i >> 2) + 4 * n + (i & 3); }

struct Unit { int pm, pn; };
struct Gemm { const f16* A; const f16* Bt; int nM, nN, K, lda, ldb, mode; };

struct StaticOrder {
    int nM, nN, nwg, G, c, mode, base, maxi, pn0, pm0;
    __device__ void init(int nM_, int nN_, int G_, int c_, int mode_) { nM = nM_; nN = nN_; nwg = nM * nN; G = G_; c = c_; mode = mode_; base = 0; maxi = 1 << 30; pn0 = 0; pm0 = 0; }
    __device__ bool next(int i, Unit& u) const {
        if (i >= maxi) return false;
        const long L = (long)base + (long)i * G + c; if (L >= nwg) return false;
        int wgid = (int)L; { const int q = nwg / NXCD, r = nwg % NXCD, xcd = wgid % NXCD, off = wgid / NXCD; wgid = (xcd < r ? xcd * (q + 1) : r * (q + 1) + (xcd - r) * q) + off; }
        const int nig = WGM * nN, gid = wgid / nig, fm = gid * WGM, gsz = (nM - fm) < WGM ? (nM - fm) : WGM;
        int pm = fm + ((wgid % nig) % gsz) + pm0; u.pn = (wgid % nig) / gsz + pn0;
        if (mode == 1) pm = (pm >> 3) * 9 + 1 + (pm & 7);
        u.pm = pm; return true;
    }
};

template <class Epi>
__device__ __forceinline__ void gemm_phase(LAS unsigned char* lds, const Gemm g, const StaticOrder& S, const Epi& E, int wv_) {
    const int tid = otid(wv_), wid = __builtin_amdgcn_readfirstlane(tid >> 6), lane = tid & 63, wr = wid >> 2, wc = wid & 3, fr = lane & 15, fq = lane >> 4;
    const int K = g.K, nt = K / BK;
    unsigned voffA[2], voffB[2];
#pragma unroll
    for (int i = 0; i < 2; ++i) { int R, C; stage_rc(tid * 16 + i * 8192, R, C); const int Rb = (R & ~31) + perm32(R & 31);
        voffA[i] = (unsigned)(R * g.lda + C) * 2u; voffB[i] = (unsigned)(Rb * g.ldb + C) * 2u; }
    const size_t kstep = (size_t)(BK * 2);
    const size_t hstepA = (size_t)HALF * g.lda * 2, hstepB = (size_t)HALF * g.ldb * 2;
    const unsigned ldsw = (unsigned)wid * 1024u;
    const int aoff = lds_byte(wr * 64 + fr, fq * 8), boff = lds_byte(wc * 32 + fr, fq * 8);
#define PG8_SA(b, h) (((b) * 2 + (h)) * HTB)
#define PG8_SB(b, h) ((4 + (b) * 2 + (h)) * HTB)
#define PG8_STAGE(bufoff, gbase, voff) do { const char* _gb = uni_ptr((const char*)(gbase)); asm volatile("" : "+s"(_gb)); _Pragma("unroll") for (int _i = 0; _i < 2; ++_i) \
        __builtin_amdgcn_global_load_lds((const unsigned*)(_gb + (voff)[_i]), (LAS unsigned*)(lds + (bufoff) + ldsw + _i * 8192), 16, 0, 0); } while (0)
#define PG8_LDA(dst, b, h) do { _Pragma("unroll") for (int m = 0; m < 4; ++m) _Pragma("unroll") for (int k = 0; k < 2; ++k) dst[m][k] = *(const LAS h8*)(lds + PG8_SA(b, h) + aoff + m * 2048 + k * 1024); } while (0)
#define PG8_LDB(dst, b, h) do { _Pragma("unroll") for (int n = 0; n < 2; ++n) _Pragma("unroll") for (int k = 0; k < 2; ++k) dst[n][k] = *(const LAS h8*)(lds + PG8_SB(b, h) + boff + n * 2048 + k * 1024); } while (0)
#define PG8_MMA(ai, bj, At, Bt) do { __builtin_amdgcn_s_setprio(1); _Pragma("unroll") for (int m = 0; m < 4; ++m) _Pragma("unroll") for (int n = 0; n < 2; ++n) _Pragma("unroll") for (int k = 0; k < 2; ++k) \
        acc[ai][bj][m][n] = __builtin_amdgcn_mfma_f32_16x16x32_f16(Bt[n][k], At[m][k], acc[ai][bj][m][n], 0, 0, 0); __builtin_amdgcn_s_setprio(0); } while (0)
#define PG8_WAIT_V(n) asm volatile("s_waitcnt vmcnt(" #n ")" ::: "memory")
#define PG8_WAIT_L(n) asm volatile("s_waitcnt lgkmcnt(" #n ")" ::: "memory")
#define PG8_BAR __builtin_amdgcn_s_barrier()
#define PG8_SCHED __builtin_amdgcn_sched_barrier(0)
#define PG8_UA(u) ((const char*)g.A + ((size_t)(u).pm * BM * g.lda + (g.mode == 2 ? (size_t)((((u).pn & 15) >> 1) * 256) : (size_t)0)) * 2)
#define PG8_UB(u) ((const char*)g.Bt + (size_t)(u).pn * BM * g.ldb * 2)
    Unit cur, nxt; int ui = 0;
    if (!S.next(0, cur)) return;
    f32x4 acc[2][2][4][2];
#pragma unroll
    for (int a = 0; a < 2; ++a)
#pragma unroll
        for (int b = 0; b < 2; ++b)
#pragma unroll
            for (int m = 0; m < 4; ++m)
#pragma unroll
                for (int n = 0; n < 2; ++n) acc[a][b][m][n] = (f32x4){0.f, 0.f, 0.f, 0.f};
    h8 At[4][2], B0[2][2], B1[2][2];
    const char* cA = PG8_UA(cur); const char* cB = PG8_UB(cur);
    PG8_STAGE(PG8_SB(0, 0), cB, voffB); PG8_STAGE(PG8_SB(0, 1), cB + hstepB, voffB); PG8_STAGE(PG8_SA(0, 0), cA, voffA); PG8_STAGE(PG8_SA(0, 1), cA + hstepA, voffA);
    if (wr == 1) PG8_BAR;
    PG8_WAIT_V(2); PG8_BAR;
    PG8_STAGE(PG8_SB(1, 0), cB + kstep, voffB); PG8_STAGE(PG8_SA(1, 0), cA + kstep, voffA); PG8_STAGE(PG8_SB(1, 1), cB + hstepB + kstep, voffB);
    PG8_WAIT_V(6); PG8_BAR;
    for (;;) {
        const bool has_next = S.next(ui + 1, nxt);
        const char* nA = has_next ? PG8_UA(nxt) : cA; const char* nB = has_next ? PG8_UB(nxt) : cB;
        for (int t = 0; t < nt; t += 2) {
            const bool last = (t == nt - 2);
            const char* a1 = cA + (size_t)(t + 1) * kstep;
            const char* a2 = last ? nA : cA + (size_t)(t + 2) * kstep; const char* b2 = last ? nB : cB + (size_t)(t + 2) * kstep;
            const char* a3 = a2 + kstep; const char* b3 = b2 + kstep;
            PG8_LDB(B0, 0, 0); PG8_LDB(B1, 0, 1); PG8_SCHED; PG8_LDA(At, 0, 0); PG8_STAGE(PG8_SA(1, 1), a1 + hstepA, voffA);
            PG8_WAIT_V(8); PG8_WAIT_L(0); PG8_BAR; PG8_MMA(0, 0, At, B0); PG8_MMA(0, 1, At, B1); PG8_BAR; PG8_SCHED;
            PG8_LDA(At, 0, 1); PG8_STAGE(PG8_SB(0, 0), b2, voffB); PG8_STAGE(PG8_SB(0, 1), b2 + hstepB, voffB); PG8_STAGE(PG8_SA(0, 0), a2, voffA);
            PG8_WAIT_V(8); PG8_WAIT_L(0); PG8_BAR; PG8_MMA(1, 0, At, B0); PG8_MMA(1, 1, At, B1); PG8_BAR; PG8_SCHED;
            PG8_LDB(B0, 1, 0); PG8_LDB(B1, 1, 1); PG8_SCHED; PG8_LDA(At, 1, 0); PG8_STAGE(PG8_SA(0, 1), a2 + hstepA, voffA);
            PG8_WAIT_V(8); PG8_WAIT_L(0); PG8_BAR; PG8_MMA(0, 0, At, B0); PG8_MMA(0, 1, At, B1); PG8_BAR; PG8_SCHED;
            PG8_LDA(At, 1, 1); PG8_STAGE(PG8_SB(1, 0), b3, voffB); PG8_STAGE(PG8_SB(1, 1), b3 + hstepB, voffB); PG8_STAGE(PG8_SA(1, 0), a3, voffA);
            PG8_WAIT_V(8); PG8_WAIT_L(0); PG8_BAR; PG8_MMA(1, 0, At, B0); PG8_MMA(1, 1, At, B1); PG8_BAR; PG8_SCHED;
        }
        if (wr == 0) PG8_BAR;
        E(acc, cur, wr, wc, fr, fq);
        if (!has_next) break;
#pragma unroll
        for (int a = 0; a < 2; ++a)
#pragma unroll
            for (int b = 0; b < 2; ++b)
#pragma unroll
                for (int m = 0; m < 4; ++m)
#pragma unroll
                    for (int n = 0; n < 2; ++n) acc[a][b][m][n] = (f32x4){0.f, 0.f, 0.f, 0.f};
        cur = nxt; cA = nA; cB = nB; ++ui;
        if (wr == 1) PG8_BAR;
    }
    PG8_WAIT_V(0);
    PG8_BAR;
#undef PG8_SA
#undef PG8_SB
#undef PG8_STAGE
#undef PG8_LDA
#undef PG8_LDB
#undef PG8_MMA
#undef PG8_UA
#undef PG8_UB
}

__device__ __forceinline__ h8 pack8(const float (&v)[8]) { h8 r;
#pragma unroll
    for (int i = 0; i < 8; ++i) r[i] = (f16)v[i];
    return r; }

struct Epi1 {
    static constexpr bool PERM = true;
    f16* R; const float* lb;
    __device__ __forceinline__ void operator()(const f32x4 (&acc)[2][2][4][2], const Unit& u, int wr, int wc, int fr, int fq) const {
        asm volatile("" : "+v"(fr), "+v"(fq));
        const int t = u.pn >> 3; f16* dst = R + (size_t)t * (SLOT / 2);
        const int row0 = u.pm * BM + wr * 64 + fr, col0 = (u.pn & 7) * 256 + wc * 32 + fq * 8;
        float lbv[2][8];
        if (t == 2 || t == 3) {
#pragma unroll
            for (int bj = 0; bj < 2; ++bj)
#pragma unroll
                for (int i = 0; i < 8; ++i) lbv[bj][i] = lb[col0 + bj * HALF + i];
        }
#pragma unroll
        for (int ai = 0; ai < 2; ++ai)
#pragma unroll
            for (int m = 0; m < 4; ++m) {
                f16* rowp = dst + (size_t)(row0 + ai * HALF + m * 16) * EI + col0;
#pragma unroll
                for (int bj = 0; bj < 2; ++bj) {
                    float v[8];
#pragma unroll
                    for (int n = 0; n < 2; ++n)
#pragma unroll
                        for (int i = 0; i < 4; ++i) v[n * 4 + i] = acc[ai][bj][m][n][i];
                    if (t == 0) {
#pragma unroll
                        for (int i = 0; i < 8; ++i) v[i] = silu(v[i]);
                    } else if (t == 2 || t == 3) {
#pragma unroll
                        for (int i = 0; i < 8; ++i) { const float l = lbv[bj][i]; v[i] = __builtin_amdgcn_logf(l + (1.f - l) * sigm(v[i])); }
                    }
                    *(h8*)(rowp + bj * HALF) = pack8(v);
                }
                asm volatile("" ::: "memory"); __builtin_amdgcn_sched_barrier(0);
            }
    }
};

struct Epi2 {
    static constexpr bool PERM = true;
    const float* x; const float* ctx; float* out; float* x1c; const float* mods; int hb;
    __device__ __forceinline__ void operator()(const f32x4 (&acc)[2][2][4][2], const Unit& u, int wr, int wc, int fr, int fq) const {
        asm volatile("" : "+v"(fr), "+v"(fq));
        const int bl = u.pm / 9, tib = u.pm % 9, b = hb * HBN + bl;
        const bool isctx = (tib == 0);
        const float* gp = mods + (size_t)(isctx ? 8 : b) * 3072 + 2048;
        const int col0 = u.pn * BM + wc * 32 + fq * 8;
        f32x4 gv[2][2];
#pragma unroll
        for (int bj = 0; bj < 2; ++bj)
#pragma unroll
            for (int n = 0; n < 2; ++n) gv[bj][n] = *(const f32x4*)(gp + col0 + bj * HALF + n * 4);
#pragma unroll
        for (int ai = 0; ai < 2; ++ai)
#pragma unroll
            for (int m2 = 0; m2 < 4; m2 += 2) {
                float* dst[2]; f32x4 xv[2][2][2];
#pragma unroll
                for (int mm = 0; mm < 2; ++mm) {
                    const int s = tib * 256 + ai * HALF + wr * 64 + (m2 + mm) * 16 + fr;
                    const float* src;
                    if (isctx) { const size_t o = ((size_t)b * TC + s) * DM; src = ctx + o; dst[mm] = x1c + o; }
                    else { const size_t o = ((size_t)b * TL + (s - TC)) * DM; src = x + o; dst[mm] = out + o; }
#pragma unroll
                    for (int bj = 0; bj < 2; ++bj)
#pragma unroll
                        for (int n = 0; n < 2; ++n) xv[mm][bj][n] = *(const f32x4*)(src + col0 + bj * HALF + n * 4);
                }
#pragma unroll
                for (int mm = 0; mm < 2; ++mm)
#pragma unroll
                    for (int bj = 0; bj < 2; ++bj)
#pragma unroll
                        for (int n = 0; n < 2; ++n) *(f32x4*)(dst[mm] + col0 + bj * HALF + n * 4) = xv[mm][bj][n] + gv[bj][n] * acc[ai][bj][m2 + mm][n];
                asm volatile("" ::: "memory"); __builtin_amdgcn_sched_barrier(0);
            }
    }
};

struct Epi3 {
    static constexpr bool PERM = true;
    f16* S;
    __device__ __forceinline__ void operator()(const f32x4 (&acc)[2][2][4][2], const Unit& u, int wr, int wc, int fr, int fq) const {
        asm volatile("" : "+v"(fr), "+v"(fq));
        const int t = u.pn >> 3; f16* dst = S + (size_t)t * (SLOT / 2);
        const int row0 = u.pm * BM + wr * 64 + fr, col0 = (u.pn & 7) * 256 + wc * 32 + fq * 8;
#pragma unroll
        for (int ai = 0; ai < 2; ++ai)
#pragma unroll
            for (int m = 0; m < 4; ++m) {
                f16* rowp = dst + (size_t)(row0 + ai * HALF + m * 16) * EI + col0;
#pragma unroll
                for (int bj = 0; bj < 2; ++bj) {
                    float v[8];
#pragma unroll
                    for (int n = 0; n < 2; ++n)
#pragma unroll
                        for (int i = 0; i < 4; ++i) v[n * 4 + i] = acc[ai][bj][m][n][i];
                    *(h8*)(rowp + bj * HALF) = pack8(v);
                }
                asm volatile("" ::: "memory"); __builtin_amdgcn_sched_barrier(0);
            }
    }
};

struct Epi4 {
    static constexpr bool PERM = true;
    f16* S;
    __device__ __forceinline__ void operator()(const f32x4 (&acc)[2][2][4][2], const Unit& u, int wr, int wc, int fr, int fq) const {
        asm volatile("" : "+v"(fr), "+v"(fq));
        const int d = u.pn >> 4, gi = u.pn & 15;
        const int ch0 = gi * 128 + wc * 32 + fq * 8;
        f16* PA = S + (size_t)(d ? 0 : 3) * (SLOT / 2); f16* PX = S + (size_t)(d ? 5 : 4) * (SLOT / 2);
        const int row0 = u.pm * BM + wr * 64 + fr;
#pragma unroll
        for (int ai = 0; ai < 2; ++ai)
#pragma unroll
            for (int m = 0; m < 4; ++m) {
                const size_t o = (size_t)(row0 + ai * HALF + m * 16) * EI + ch0;
#pragma unroll
                for (int bj = 0; bj < 2; ++bj) {
                    float v[8];
#pragma unroll
                    for (int n = 0; n < 2; ++n)
#pragma unroll
                        for (int i = 0; i < 4; ++i) v[n * 4 + i] = acc[ai][bj][m][n][i];
                    *(h8*)((bj ? PX : PA) + o) = pack8(v);
                }
                asm volatile("" ::: "memory"); __builtin_amdgcn_sched_barrier(0);
            }
    }
};

struct Epi5 {
    static constexpr bool PERM = true;
    float* out; const float* mods; int hb;
    __device__ __forceinline__ void operator()(const f32x4 (&acc)[2][2][4][2], const Unit& u, int wr, int wc, int fr, int fq) const {
        asm volatile("" : "+v"(fr), "+v"(fq));
        const int bl = u.pm / 9, tib = u.pm % 9, b = hb * HBN + bl;
        const float* gp = mods + (size_t)b * 3072 + 2048;
        const int col0 = u.pn * BM + wc * 32 + fq * 8;
        f32x4 gv[2][2];
#pragma unroll
        for (int bj = 0; bj < 2; ++bj)
#pragma unroll
            for (int n = 0; n < 2; ++n) gv[bj][n] = *(const f32x4*)(gp + col0 + bj * HALF + n * 4);
#pragma unroll
        for (int ai = 0; ai < 2; ++ai)
#pragma unroll
            for (int m2 = 0; m2 < 4; m2 += 2) {
                float* dst[2]; f32x4 xv[2][2][2];
#pragma unroll
                for (int mm = 0; mm < 2; ++mm) {
                    const int p = (tib - 1) * 256 + ai * HALF + wr * 64 + (m2 + mm) * 16 + fr;
                    const int t = (p & 31) * 64 + (p >> 5);
                    dst[mm] = out + ((size_t)b * TL + t) * DM;
#pragma unroll
                    for (int bj = 0; bj < 2; ++bj)
#pragma unroll
                        for (int n = 0; n < 2; ++n) xv[mm][bj][n] = *(const f32x4*)(dst[mm] + col0 + bj * HALF + n * 4);
                }
#pragma unroll
                for (int mm = 0; mm < 2; ++mm)
#pragma unroll
                    for (int bj = 0; bj < 2; ++bj)
#pragma unroll
                        for (int n = 0; n < 2; ++n) *(f32x4*)(dst[mm] + col0 + bj * HALF + n * 4) = xv[mm][bj][n] + gv[bj][n] * acc[ai][bj][m2 + mm][n];
                asm volatile("" ::: "memory"); __builtin_amdgcn_sched_barrier(0);
            }
    }
};
}

struct TrJob { const float* src; f16* dst; int lds_n, ldd, k0, n0; };
__device__ __forceinline__ TrJob tr_decode(const Params& p, int job) {
    f16* win0t = (f16*)(p.ws + WS_WIN0T); f16* wout0t = (f16*)(p.ws + WS_WOUT0T); f16* win1t = (f16*)(p.ws + WS_WIN1T);
    f16* wout1t = (f16*)(p.ws + WS_WOUT1T); f16* wco = (f16*)(p.ws + WS_WCO);
    TrJob t;
    if (job < 2560) { const int kt = job / 160, ntl = job % 160; t = TrJob{p.hg_w_in, win0t, 10240, 1024, kt * 64, ntl * 64}; }
    else if (job < 3072) { const int j = job - 2560, kt = j / 16, ntl = j % 16; t = TrJob{p.hg_w_out, wout0t, 1024, 2048, kt * 64, ntl * 64}; }
    else if (job < 4096) { const int j = job - 3072, kt = j / 64, ntl = j % 64; t = TrJob{p.rg_w_in, win1t, 4096, 1024, kt * 64, ntl * 64}; }
    else if (job < 4608) { const int j = job - 4096, kt = j / 16, ntl = j % 16; t = TrJob{p.rg_w_out, wout1t, 1024, 2048, kt * 64, ntl * 64}; }
    else { const int j = job - 4608, mat = j / 16, tl = j % 16, kt = tl / 4, ntl = tl % 4;
        const int hh = mat & 7, which = (mat >> 3) & 1, d = mat >> 4;
        const float* s = (which ? p.rg_w_x : p.rg_w_a) + (size_t)(d * 8 + hh) * 256 * 256;
        const int n0 = ntl * 64;
        f16* dst = wco + (size_t)((d * 16 + hh * 2 + (n0 >> 7)) * 256 + which * 128 + (n0 & 127)) * 256;
        t = TrJob{s, dst - (size_t)n0 * 256, 256, 256, kt * 64, n0}; }
    return t;
}
__device__ __forceinline__ void phase_transposes(const Params& p, unsigned char* lds, int wv_, int j0, int j1, int vb, int VG) {
    float* tile = (float*)lds;
    const int tid = otid(wv_);
    for (int job = j0 + vb; job < j1; job += 2 * VG) {
        const bool two = (job + VG < j1);
        const TrJob a = tr_decode(p, job), b = tr_decode(p, two ? job + VG : job);
        __syncthreads();
        float va[8], vb2[8];
#pragma unroll
        for (int i = 0; i < 8; ++i) { const int idx = tid + i * 512, kk = idx >> 6, nn = idx & 63;
            va[i] = a.src[(size_t)(a.k0 + kk) * a.lds_n + a.n0 + nn]; vb2[i] = b.src[(size_t)(b.k0 + kk) * b.lds_n + b.n0 + nn]; }
#pragma unroll
        for (int i = 0; i < 8; ++i) { const int idx = tid + i * 512, kk = idx >> 6, nn = idx & 63; tile[kk * 65 + nn] = va[i]; tile[4160 + kk * 65 + nn] = vb2[i]; }
        __syncthreads();
#pragma unroll
        for (int i = 0; i < 4; ++i) { const int idx = tid + i * 512, nn = idx >> 5, kp = idx & 31;
            h2 v; v[0] = (f16)tile[(2 * kp) * 65 + nn]; v[1] = (f16)tile[(2 * kp + 1) * 65 + nn];
            *(h2*)(a.dst + (size_t)(a.n0 + nn) * a.ldd + a.k0 + 2 * kp) = v;
            if (two) { h2 w2; w2[0] = (f16)tile[4160 + (2 * kp) * 65 + nn]; w2[1] = (f16)tile[4160 + (2 * kp + 1) * 65 + nn];
                *(h2*)(b.dst + (size_t)(b.n0 + nn) * b.ldd + b.k0 + 2 * kp) = w2; } }
    }
}

__device__ __forceinline__ void phase0(const Params& p, unsigned char* lds, int wv_) {
    const int tid = otid(wv_), G = gridDim.x;
    float* mods = (float*)(p.ws + WS_MODS);
    { const int idx = blockIdx.x * 512 + tid;
      if (idx < EI) { const float a = p.hg_lb[idx], b = p.hg_lb[EI + idx], c = p.hg_lb[2 * EI + idx]; const float m = fmaxf(a, fmaxf(b, c));
          const float ea = fexp(a - m), eb = fexp(b - m), ec = fexp(c - m); ((float*)(p.ws + WS_LB0))[idx] = ea / (ea + eb + ec); } }
    { const int idx = blockIdx.x * 512 + tid;
      if (idx < 2 * EI) ((f32x4*)(p.ws + WS_COEF))[idx] = (f32x4){p.rg_b_a[idx], p.rg_b_x[idx], -8.f * log1pf(fexp(-p.rg_lambda[idx])), 0.f}; }
    float* sc = (float*)lds;
    float* red = sc + 9 * 1024;
    for (int item = blockIdx.x; item < 192; item += G) {
        const int l = item / 96, n0 = (item % 96) * 32;
        __syncthreads();
        for (int i = tid; i < 9 * 1024; i += 512) { const int j = i >> 10, k = i & 1023; const float v = (j < 8) ? p.c[j * 1024 + k] : p.c_ctx[k]; sc[i] = silu(v); }
        __syncthreads();
        const int col = tid & 31, ks = tid >> 5;
        float a[9];
#pragma unroll
        for (int j = 0; j < 9; ++j) a[j] = 0.f;
        const float* w = p.ada_w + (size_t)l * 1024 * 3072 + n0 + col;
#pragma unroll 8
        for (int k = ks * 64; k < ks * 64 + 64; ++k) { const float wv = w[(size_t)k * 3072];
#pragma unroll
            for (int j = 0; j < 9; ++j) a[j] += sc[j * 1024 + k] * wv; }
#pragma unroll
        for (int j = 0; j < 9; ++j) red[(ks * 9 + j) * 32 + col] = a[j];
        __syncthreads();
        if (tid < 288) { const int j = tid >> 5, cc = tid & 31; float s = p.ada_b[l * 3072 + n0 + cc];
            for (int q = 0; q < 16; ++q) s += red[(q * 9 + j) * 32 + cc];
            mods[(size_t)(l * 9 + j) * 3072 + n0 + cc] = s; }
    }
    phase_transposes(p, lds, wv_, 0, 3072, blockIdx.x, G);
}

template <int LAYER>
__device__ __forceinline__ void phase_h(const Params& p, int hb, int wv_, int vb, int VG) {
    const int tid_ = otid(wv_), lane = tid_ & 63, wid = tid_ >> 6;
    const float* mods = (const float*)(p.ws + WS_MODS) + (size_t)LAYER * 9 * 3072;
    const float* g = p.norm_g + LAYER * DM;
    f16* H = (f16*)(p.ws + (LAYER == 0 ? WS_H : WS_S + (size_t)(hb ? 5 : 4) * SLOT));
    const float* x1c = (const float*)(p.ws + WS_X1C);
    for (int r = vb * 8 + wid; r < MH; r += VG * 8) {
        const int bl = r / TS, s = r % TS, b = hb * HBN + bl;
        const float* src; int j;
        if (s < TC) { j = 8; src = (LAYER == 0 ? p.ctx : x1c) + ((size_t)b * TC + s) * DM; }
        else { j = b; const int q = s - TC; const int t = (LAYER == 0) ? q : ((q & 31) * 64 + (q >> 5));
               src = (LAYER == 0 ? p.x : (const float*)p.out) + ((size_t)b * TL + t) * DM; }
        const float* md = mods + (size_t)j * 3072;
        f32x4 v[4]; float ss = 0.f;
#pragma unroll
        for (int i = 0; i < 4; ++i) { v[i] = *(const f32x4*)(src + lane * 4 + i * 256); ss += v[i][0] * v[i][0] + v[i][1] * v[i][1] + v[i][2] * v[i][2] + v[i][3] * v[i][3]; }
        ss = wave_sum(ss, lane);
        const float rs = __builtin_amdgcn_rsqf(ss * (1.f / DM) + 1e-6f);
#pragma unroll
        for (int i = 0; i < 4; ++i) { const int k = lane * 4 + i * 256;
            const f32x4 gg = *(const f32x4*)(g + k), sh = *(const f32x4*)(md + k), scl = *(const f32x4*)(md + 1024 + k);
            h4 o;
#pragma unroll
            for (int e = 0; e < 4; ++e) o[e] = (f16)(v[i][e] * rs * gg[e] * (1.f + scl[e]) + sh[e]);
            *(h4*)(H + (size_t)r * DM + k) = o; }
    }
}

typedef short s4v __attribute__((__vector_size__(8)));
typedef short s8 __attribute__((ext_vector_type(8)));
__device__ __forceinline__ unsigned short f2bf(float x) { unsigned r; asm("v_cvt_pk_bf16_f32 %0, %1, %1" : "=v"(r) : "v"(x)); return (unsigned short)r; }
__device__ __forceinline__ h8 join4(s4v a, s4v b) { typedef short s8v __attribute__((__vector_size__(16))); s8v r = __builtin_shufflevector(a, b, 0, 1, 2, 3, 4, 5, 6, 7); return __builtin_bit_cast(h8, r); }
__device__ __forceinline__ h8 trread8(const LAS f16* a, int rs4) {
    const s4v r0 = __builtin_amdgcn_ds_read_tr16_b64_v4i16((LAS s4v*)a), r1 = __builtin_amdgcn_ds_read_tr16_b64_v4i16((LAS s4v*)(a + rs4));
    return join4(r0, r1); }
constexpr int HRS = 136, HPS = 72;
__device__ __forceinline__ void hg_score_block(const LAS unsigned short* Kside, const LAS unsigned short* Qd, LAS f16* P, int I, int J, bool diag, int l15, int quad) {
    f32x4 acc = (f32x4){0.f, 0.f, 0.f, 0.f};
#pragma unroll
    for (int kk = 0; kk < 4; ++kk) {
        const s8 a = *(const LAS s8*)(Kside + l15 * HRS + 32 * kk + 8 * quad);
        const s8 b = *(const LAS s8*)(Qd + (16 * I + l15) * HRS + 32 * kk + 8 * quad);
        acc = __builtin_amdgcn_mfma_f32_16x16x32_bf16(a, b, acc, 0, 0, 0);
    }
    h4 o;
#pragma unroll
    for (int jj = 0; jj < 4; ++jj) { float v = acc[jj]; if (diag && (4 * quad + jj > l15)) v = 0.f; o[jj] = (f16)v; }
    *(LAS h4*)(P + (16 * I + l15) * HPS + 16 * J + 4 * quad) = o;
}

#define HG_LBAR() do { asm volatile("s_waitcnt lgkmcnt(0)" ::: "memory"); __builtin_amdgcn_s_barrier(); asm volatile("" ::: "memory"); } while (0)
__device__ __forceinline__ void phase_hgrn(const Params& p, LAS unsigned char* lds, int wv_) {
    const int tid = otid(wv_), lane = tid & 63, w = __builtin_amdgcn_readfirstlane(tid >> 6), l15 = lane & 15, quad = lane >> 4;
    LAS f16* Vs = (LAS f16*)lds; LAS f16* Qe = Vs + 64 * HRS; LAS unsigned short* Qd = (LAS unsigned short*)(Qe + 64 * HRS); LAS f16* Kd = (LAS f16*)(Qd + 64 * HRS);
    LAS unsigned short* Kdg = (LAS unsigned short*)(Kd + 64 * HRS); LAS unsigned short* Kx = Kdg + 64 * HRS; LAS f16* P = (LAS f16*)(Kx + 6 * 16 * HRS);
    LAS float* Tj = (LAS float*)(P + 64 * HPS); LAS float* Dk = Tj + 512;
    LAS f16* RQ = (LAS f16*)(lds + 124928); LAS f16* RL = RQ + 64 * HRS;
    const int vrow = tid >> 3, vc16 = (tid & 7) * 16;
    const f16* Qg = (const f16*)(p.ws + WS_R); const f16* Vg = Qg + SLOT / 2;
    h8 Ltri[2];
#pragma unroll
    for (int hf = 0; hf < 2; ++hf)
#pragma unroll
        for (int jx = 0; jx < 8; ++jx) { const int s32 = 8 * quad + jx; Ltri[hf][jx] = (((s32 >> 4) == hf) && ((s32 & 15) <= l15)) ? (f16)1.f : (f16)0.f; }
    __syncthreads();
    for (int i = tid; i < 64 * HPS / 2; i += 512) ((LAS unsigned*)P)[i] = 0u;
    for (int chain = blockIdx.x; chain < 128; chain += gridDim.x) {
        const int dir = chain & 1, h = (chain >> 1) & 15, bl = chain >> 5;
        f16* LFg = (f16*)(p.ws + WS_R) + (size_t)(2 + dir) * (SLOT / 2);
        f32x4 S[8];
#pragma unroll
        for (int i = 0; i < 8; ++i) S[i] = (f32x4){0.f, 0.f, 0.f, 0.f};
        h8 qv[2][2], lv[2][2], vr[2][2];
#if PROBE_ON == 2
        if (blockIdx.x == 0 && tid == 0) { unsigned long long* ta = (unsigned long long*)(p.ws + WS_TS); ta[19] = wall_clock64(); }
#endif
        {
            const int cpos = dir ? 3 : 0; const size_t base = ((size_t)bl * TS + cpos * 64) * EI + h * 128;
            const int row = dir ? 63 - vrow : vrow; const size_t o = base + (size_t)row * EI + vc16;
            qv[0][0] = *(const h8*)(Qg + o); qv[0][1] = *(const h8*)(Qg + o + 8); lv[0][0] = *(const h8*)(LFg + o); lv[0][1] = *(const h8*)(LFg + o + 8);
            vr[0][0] = *(const h8*)(Vg + o); vr[0][1] = *(const h8*)(Vg + o + 8);
        }
        __syncthreads();
        *(LAS h8*)(RQ + vrow * HRS + vc16) = qv[0][0]; *(LAS h8*)(RQ + vrow * HRS + vc16 + 8) = qv[0][1];
        *(LAS h8*)(RL + vrow * HRS + vc16) = lv[0][0]; *(LAS h8*)(RL + vrow * HRS + vc16 + 8) = lv[0][1];
        {
            const int cpos = dir ? 2 : 1; const size_t base = ((size_t)bl * TS + cpos * 64) * EI + h * 128;
            const int row = dir ? 63 - vrow : vrow; const size_t o = base + (size_t)row * EI + vc16;
            qv[1][0] = *(const h8*)(Qg + o); qv[1][1] = *(const h8*)(Qg + o + 8); lv[1][0] = *(const h8*)(LFg + o); lv[1][1] = *(const h8*)(LFg + o + 8);
            vr[1][0] = *(const h8*)(Vg + o); vr[1][1] = *(const h8*)(Vg + o + 8);
        }
        __syncthreads();
        for (int cc2 = 0; cc2 < 36; cc2 += 2) {
#pragma unroll
        for (int hs = 0; hs < 2; ++hs) {
            const int cc = cc2 + hs;
            const int cpos = dir ? (cc < 4 ? 3 - cc : 39 - cc) : cc;
            const size_t base = ((size_t)bl * TS + cpos * 64) * EI + h * 128;
            *(LAS h8*)(Vs + vrow * HRS + vc16) = vr[hs][0]; *(LAS h8*)(Vs + vrow * HRS + vc16 + 8) = vr[hs][1];
            f32x4 cacc[4];
#pragma unroll
            for (int ks = 0; ks < 2; ++ks) {
                const h8 lfT = trread8(RL + (32 * ks + 8 * quad + (l15 >> 2)) * HRS + 16 * w + 4 * (l15 & 3), 4 * HRS);
#pragma unroll
                for (int hf = 0; hf < 2; ++hf) cacc[2 * ks + hf] = __builtin_amdgcn_mfma_f32_16x16x32_f16(lfT, Ltri[hf], (f32x4){0.f, 0.f, 0.f, 0.f}, 0, 0, 0);
            }
            f32x4 eT[4];
#pragma unroll
            for (int I = 0; I < 4; ++I)
#pragma unroll
                for (int jj = 0; jj < 4; ++jj) eT[I][jj] = __builtin_amdgcn_exp2f(__int_as_float(__builtin_amdgcn_ds_bpermute(((lane & 48) | 15) << 2, __float_as_int(cacc[I][jj]))));
            const f32x4 e12 = eT[1] * eT[2];
            f32x4 eBs[4], eEnd[4];
            eBs[0] = (f32x4){1.f, 1.f, 1.f, 1.f}; eBs[1] = eT[0]; eBs[2] = eT[0] * eT[1]; eBs[3] = eBs[2] * eT[2];
            eEnd[3] = (f32x4){1.f, 1.f, 1.f, 1.f}; eEnd[2] = eT[3]; eEnd[1] = eT[2] * eT[3]; eEnd[0] = e12 * eT[3];
            if (l15 == 0) *(LAS f32x4*)(Dk + 16 * w + 4 * quad) = eBs[3] * eT[3];
            typedef float f32x2 __attribute__((ext_vector_type(2)));
            typedef unsigned u32x2 __attribute__((ext_vector_type(2)));
#pragma unroll
            for (int I = 0; I < 4; ++I) {
                const int o = (16 * I + l15) * HRS + 16 * w + 4 * quad;
                const h4 q4 = *(const LAS h4*)(RQ + o), l4 = *(const LAS h4*)(RL + o);
                u32x2 qdp, kgp, kx0p, kx1p, kx2p; h4 qe4, kd4;
#pragma unroll
                for (int pr = 0; pr < 2; ++pr) {
                    const int j0 = 2 * pr, j1 = 2 * pr + 1;
                    const f32x2 ci = {fmaxf(cacc[I][j0], -86.f), fmaxf(cacc[I][j1], -86.f)};
                    const f32x2 e1 = {__builtin_amdgcn_exp2f(ci.x), __builtin_amdgcn_exp2f(ci.y)};
                    const f32x2 inv = {__builtin_amdgcn_rcpf(e1.x), __builtin_amdgcn_rcpf(e1.y)};
                    const f32x2 fg = {__builtin_amdgcn_exp2f((float)l4[j0]), __builtin_amdgcn_exp2f((float)l4[j1])};
                    const f32x2 kk = (f32x2){1.f, 1.f} - fg;
                    const f32x2 qq = {(float)q4[j0], (float)q4[j1]};
                    const f32x2 qd = qq * e1;
                    const f32x2 qe = qd * (f32x2){eBs[I][j0], eBs[I][j1]};
                    const f32x2 kg = kk * inv;
                    const f32x2 kx = kg * (f32x2){eT[I][j0], eT[I][j1]};
                    const f32x2 kd = kx * (f32x2){eEnd[I][j0], eEnd[I][j1]};
                    const f32x2 k1 = kx * (I == 0 ? (f32x2){eT[1][j0], eT[1][j1]} : (f32x2){eT[2][j0], eT[2][j1]});
                    const f32x2 k2 = kx * (f32x2){e12[j0], e12[j1]};
                    unsigned t0, t1, t2, t3, t4;
                    asm("v_cvt_pk_bf16_f32 %0, %1, %2" : "=v"(t0) : "v"(qd.x), "v"(qd.y));
                    asm("v_cvt_pk_bf16_f32 %0, %1, %2" : "=v"(t1) : "v"(kg.x), "v"(kg.y));
                    asm("v_cvt_pk_bf16_f32 %0, %1, %2" : "=v"(t2) : "v"(kx.x), "v"(kx.y));
                    asm("v_cvt_pk_bf16_f32 %0, %1, %2" : "=v"(t3) : "v"(k1.x), "v"(k1.y));
                    asm("v_cvt_pk_bf16_f32 %0, %1, %2" : "=v"(t4) : "v"(k2.x), "v"(k2.y));
                    qdp[pr] = t0; kgp[pr] = t1; kx0p[pr] = t2; kx1p[pr] = t3; kx2p[pr] = t4;
                    qe4[j0] = (f16)qe.x; qe4[j1] = (f16)qe.y; kd4[j0] = (f16)kd.x; kd4[j1] = (f16)kd.y;
                }
                *(LAS u32x2*)(Qd + o) = qdp;
                *(LAS h4*)(Qe + (16 * I + l15) * HRS + 32 * (w >> 1) + 8 * quad + 4 * (w & 1)) = qe4;
                *(LAS u32x2*)(Kdg + o) = kgp;
                *(LAS h4*)(Kd + o) = kd4;
                const int basej = (I == 0) ? 0 : (I == 1 ? 3 : 5); const int ox = l15 * HRS + 16 * w + 4 * quad;
                if (I < 3) *(LAS u32x2*)(Kx + basej * 16 * HRS + ox) = kx0p;
                if (I < 2) *(LAS u32x2*)(Kx + (basej + 1) * 16 * HRS + ox) = kx1p;
                if (I < 1) *(LAS u32x2*)(Kx + (basej + 2) * 16 * HRS + ox) = kx2p;
            }
            HG_LBAR();
#if PROBE_ON == 2
            if (blockIdx.x == 0 && tid == 0) { unsigned long long* ta = (unsigned long long*)(p.ws + WS_TS); const unsigned long long n = wall_clock64(); ta[16] += n - ta[19]; ta[19] = n; }
#endif
            if (cc < 34) {
                const int cn = cc + 2, cposn = dir ? (cn < 4 ? 3 - cn : 39 - cn) : cn; const size_t bn = ((size_t)bl * TS + cposn * 64) * EI + h * 128;
                const int row = dir ? 63 - vrow : vrow; const size_t o = bn + (size_t)row * EI + vc16;
                qv[hs][0] = *(const h8*)(Qg + o); qv[hs][1] = *(const h8*)(Qg + o + 8); lv[hs][0] = *(const h8*)(LFg + o); lv[hs][1] = *(const h8*)(LFg + o + 8);
                vr[hs][0] = *(const h8*)(Vg + o); vr[hs][1] = *(const h8*)(Vg + o + 8);
            }
            if (w < 4) hg_score_block(Kdg + 16 * w * HRS, Qd, P, w, w, true, l15, quad);
            if (w == 4) hg_score_block(Kx + 0 * 16 * HRS, Qd, P, 1, 0, false, l15, quad);
            if (w == 5) hg_score_block(Kx + 1 * 16 * HRS, Qd, P, 2, 0, false, l15, quad);
            if (w == 6) hg_score_block(Kx + 3 * 16 * HRS, Qd, P, 2, 1, false, l15, quad);
            if (w == 7) hg_score_block(Kx + 2 * 16 * HRS, Qd, P, 3, 0, false, l15, quad);
            if (w == 0) hg_score_block(Kx + 4 * 16 * HRS, Qd, P, 3, 1, false, l15, quad);
            if (w == 1) hg_score_block(Kx + 5 * 16 * HRS, Qd, P, 3, 2, false, l15, quad);
            h8 BV[2];
#pragma unroll
            for (int ks = 0; ks < 2; ++ks) BV[ks] = trread8(Vs + (32 * ks + 8 * quad + (l15 >> 2)) * HRS + 16 * w + 4 * (l15 & 3), 4 * HRS);
            f32x4 oacc[4];
            {
                h8 Sf[4];
#pragma unroll
                for (int kk = 0; kk < 4; ++kk)
#pragma unroll
                    for (int e = 0; e < 4; ++e) { Sf[kk][e] = (f16)S[2 * kk][e]; Sf[kk][4 + e] = (f16)S[2 * kk + 1][e]; }
#pragma unroll
                for (int I = 0; I < 4; ++I) {
                    f32x4 o = (f32x4){0.f, 0.f, 0.f, 0.f};
#pragma unroll
                    for (int kk = 0; kk < 4; ++kk) { const h8 qf = *(const LAS h8*)(Qe + (16 * I + l15) * HRS + 32 * kk + 8 * quad);
                        o = __builtin_amdgcn_mfma_f32_16x16x32_f16(Sf[kk], qf, o, 0, 0, 0); }
                    oacc[I] = o;
                }
            }
#pragma unroll
            for (int kt = 0; kt < 8; ++kt) {
                const f32x4 dk = *(const LAS f32x4*)(Dk + 16 * kt + 4 * quad);
                S[kt] = S[kt] * dk;
#pragma unroll
                for (int ks = 0; ks < 2; ++ks) { const h8 af = trread8(Kd + (32 * ks + 8 * quad + (l15 >> 2)) * HRS + 16 * kt + 4 * (l15 & 3), 4 * HRS);
                    S[kt] = __builtin_amdgcn_mfma_f32_16x16x32_f16(af, BV[ks], S[kt], 0, 0, 0); }
            }
            HG_LBAR();
#if PROBE_ON == 2
            if (blockIdx.x == 0 && tid == 0) { unsigned long long* ta = (unsigned long long*)(p.ws + WS_TS); const unsigned long long n = wall_clock64(); ta[17] += n - ta[19]; ta[19] = n; }
#endif
#pragma unroll
            for (int I = 0; I < 4; ++I) {
                f32x4 o = oacc[I];
                { const h8 pf = *(const LAS h8*)(P + (16 * I + l15) * HPS + 8 * quad); o = __builtin_amdgcn_mfma_f32_16x16x32_f16(BV[0], pf, o, 0, 0, 0); }
                if (I >= 2) { const h8 pf = *(const LAS h8*)(P + (16 * I + l15) * HPS + 32 + 8 * quad); o = __builtin_amdgcn_mfma_f32_16x16x32_f16(BV[1], pf, o, 0, 0, 0); }
                const int t = 16 * I + l15, row = dir ? 63 - t : t;
                h4 ov;
#pragma unroll
                for (int e = 0; e < 4; ++e) ov[e] = (f16)o[e];
                *(h4*)(LFg + base + (size_t)row * EI + 16 * w + 4 * quad) = ov;
            }
            if (cc < 35) {
                *(LAS h8*)(RQ + vrow * HRS + vc16) = qv[hs ^ 1][0]; *(LAS h8*)(RQ + vrow * HRS + vc16 + 8) = qv[hs ^ 1][1];
                *(LAS h8*)(RL + vrow * HRS + vc16) = lv[hs ^ 1][0]; *(LAS h8*)(RL + vrow * HRS + vc16 + 8) = lv[hs ^ 1][1];
            }
            HG_LBAR();
#if PROBE_ON == 2
            if (blockIdx.x == 0 && tid == 0) { unsigned long long* ta = (unsigned long long*)(p.ws + WS_TS); const unsigned long long n = wall_clock64(); ta[18] += n - ta[19]; ta[19] = n; }
#endif
        }
        }
    }
}

__device__ __forceinline__ void phase_readout(const Params& p, int wv_) {
    const int tid_ = otid(wv_), lane = tid_ & 63, wid = tid_ >> 6;
    f16* OF = (f16*)(p.ws + WS_R) + (size_t)2 * (SLOT / 2); const f16* OB = OF + SLOT / 2; const f16* Gt = OB + SLOT / 2;
    for (int it = blockIdx.x * 8 + wid; it < 2 * MH; it += gridDim.x * 8) {
        const int r = it >> 1, ch0 = (it & 1) * 1024 + lane * 16;
        const size_t o = (size_t)r * EI + ch0;
        float v[16]; float ss = 0.f;
#pragma unroll
        for (int q = 0; q < 2; ++q) { const h8 a = *(const h8*)(OF + o + q * 8), b = *(const h8*)(OB + o + q * 8);
#pragma unroll
            for (int e = 0; e < 8; ++e) { const float s = (float)a[e] + (float)b[e]; v[q * 8 + e] = s; ss += s * s; } }
        ss += shx(ss, lane, 1); ss += shx(ss, lane, 2); ss += shx(ss, lane, 4);
        const float rs = __builtin_amdgcn_rsqf(ss * (1.f / 128.f) + 1e-6f);
#pragma unroll
        for (int q = 0; q < 2; ++q) { const h8 gt = *(const h8*)(Gt + o + q * 8); float ov[8];
#pragma unroll
            for (int e = 0; e < 8; ++e) ov[e] = v[q * 8 + e] * rs * p.hg_norm_g[ch0 + q * 8 + e] * silu((float)gt[e]);
            *(h8*)((f16*)Gt + o + q * 8) = pg8::pack8(ov); }
    }
}

__device__ __forceinline__ void phase_conv(const Params& p, int wv_, int vb, int VG) {
    const f16* XB = (const f16*)(p.ws + WS_S); f16* XC = (f16*)(p.ws + WS_S) + (size_t)2 * (SLOT / 2);
    const int tid_ = otid(wv_);
    const int ch = (tid_ & 255) * 8, rsub = tid_ >> 8;
    float w[4][8], bias[8];
#pragma unroll
    for (int e = 0; e < 8; ++e) { bias[e] = p.rg_conv_b[ch + e];
#pragma unroll
        for (int j = 0; j < 4; ++j) w[j][e] = p.rg_conv_w[j * EI + ch + e]; }
    for (int r0 = vb * 8; r0 < MH; r0 += VG * 8) {
        h8 xv[4][4]; bool ok[4][4];
#pragma unroll
        for (int i = 0; i < 4; ++i) { const int r = r0 + rsub + 2 * i, s = r % TS; const int lo = (s < TC) ? 0 : TC, hi = (s < TC) ? TC : TS;
#pragma unroll
            for (int j = 0; j < 4; ++j) { const int ss = s - 2 + j; ok[i][j] = (ss >= lo && ss < hi);
                xv[i][j] = ok[i][j] ? *(const h8*)(XB + (size_t)(r - 2 + j) * EI + ch) : (h8){0, 0, 0, 0, 0, 0, 0, 0}; } }
#pragma unroll
        for (int i = 0; i < 4; ++i) { const int r = r0 + rsub + 2 * i; float a[8];
#pragma unroll
            for (int e = 0; e < 8; ++e) a[e] = bias[e];
#pragma unroll
            for (int j = 0; j < 4; ++j)
#pragma unroll
                for (int e = 0; e < 8; ++e) a[e] += w[j][e] * (float)xv[i][j][e];
            *(h8*)(XC + (size_t)r * EI + ch) = pg8::pack8(a); }
    }
}

constexpr int SEGL = 72, NSEG = 32;
__device__ __forceinline__ int rg_pos2s(int p, int dir) { return dir ? (p < TC ? TC - 1 - p : TS + TC - 1 - p) : p; }
__device__ __forceinline__ void phase_scan_local(const Params& p, int wv_) {
    f16* Sb = (f16*)(p.ws + WS_S); f32x4* segt = (f32x4*)(p.ws + WS_SEGT); const f32x4* coef = (const f32x4*)(p.ws + WS_COEF);
    const f16* XC = Sb + (size_t)2 * (SLOT / 2);
    const int tid_ = otid(wv_);
    for (int idx = blockIdx.x * 512 + tid_; idx < HBN * 2 * NSEG * 1024; idx += gridDim.x * 512) {
        const int cp = idx & 1023, seg = (idx >> 10) & (NSEG - 1), dir = (idx >> 15) & 1, bl = idx >> 16;
        f16* LA = Sb + (size_t)(dir ? 0 : 3) * (SLOT / 2); f16* U = Sb + (size_t)(dir ? 5 : 4) * (SLOT / 2);
        const f32x4 c0 = coef[dir * EI + cp * 2], c1 = coef[dir * EI + cp * 2 + 1];
        const size_t base = (size_t)bl * TS * EI + cp * 2;
        float h0 = 0.f, h1 = 0.f, L0 = 0.f, L1 = 0.f;
        for (int i0 = 0; i0 < SEGL; i0 += 12) {
            h2 la[12], u[12], xc[12];
#pragma unroll
            for (int i = 0; i < 12; ++i) { const size_t o = base + (size_t)rg_pos2s(seg * SEGL + i0 + i, dir) * EI; la[i] = *(const h2*)(LA + o); u[i] = *(const h2*)(U + o); xc[i] = *(const h2*)(XC + o); }
#pragma unroll
            for (int i = 0; i < 12; ++i) {
#pragma unroll
                for (int e = 0; e < 2; ++e) {
                    const f32x4 cc = e ? c1 : c0;
                    const float ea = fexp(fminf(-((float)la[i][e] + cc[0]), 40.f)), ex = fexp(fminf(-((float)u[i][e] + cc[1]), 40.f));
                    const float R = __builtin_amdgcn_rcpf((1.f + ea) * (1.f + ex));
                    const float r = (1.f + ex) * R, ig = (1.f + ea) * R;
                    const float l = r * cc[2], a = fexp(l), y = 2.f * l;
                    const float poly = -y * (1.f + y * (0.5f + y * (0.16666667f + y * 0.041666668f)));
                    const float om = (y > -0.125f) ? poly : 1.f - a * a;
                    const float uu = fsqrt(om) * ig * (float)xc[i][e];
                    float& hh = e ? h1 : h0; float& LL = e ? L1 : L0;
                    hh = a * hh + uu; LL += l;
                    u[i][e] = (f16)hh; la[i][e] = (f16)LL;
                }
            }
#pragma unroll
            for (int i = 0; i < 12; ++i) { const size_t o = base + (size_t)rg_pos2s(seg * SEGL + i0 + i, dir) * EI; *(h2*)(U + o) = u[i]; *(h2*)(LA + o) = la[i]; }
        }
        segt[(size_t)((bl * 2 + dir) * NSEG + seg) * 1024 + cp] = (f32x4){L0, h0, L1, h1};
    }
}

__device__ __forceinline__ void phase_scan_final(const Params& p, int wv_) {
    f16* Sb = (f16*)(p.ws + WS_S); const f32x4* segt = (const f32x4*)(p.ws + WS_SEGT);
    const f16* LAf = Sb + (size_t)3 * (SLOT / 2); const f16* Uf = Sb + (size_t)4 * (SLOT / 2); const f16* LAb = Sb; const f16* Ub = Sb + (size_t)5 * (SLOT / 2);
    f16* G1 = Sb + (size_t)1 * (SLOT / 2);
    const int tid_ = otid(wv_);
    for (int idx = blockIdx.x * 512 + tid_; idx < HBN * NSEG * 1024; idx += gridDim.x * 512) {
        const int cp = idx & 1023, seg = (idx >> 10) & (NSEG - 1), bl = idx >> 15;
        if (seg * SEGL + SEGL <= TC) continue;
        const f32x4* sf = segt + (size_t)((bl * 2 + 0) * NSEG) * 1024 + cp; const f32x4* sb = segt + (size_t)((bl * 2 + 1) * NSEG) * 1024 + cp;
        float cf0 = 0.f, cf1 = 0.f;
#pragma unroll 4
        for (int sg = 0; sg < seg; ++sg) { const f32x4 t = sf[(size_t)sg * 1024]; cf0 = fexp(t[0]) * cf0 + t[1]; cf1 = fexp(t[2]) * cf1 + t[3]; }
        const int s_first = (seg * SEGL > TC) ? seg * SEGL : TC;
        const int jhi = (TS + TC - 1 - s_first) / SEGL, jlo = (TS + TC - 1 - (seg * SEGL + SEGL - 1)) / SEGL;
        float ch0 = 0.f, ch1 = 0.f, cl0 = 0.f, cl1 = 0.f;
#pragma unroll 4
        for (int sg = 0; sg < jhi; ++sg) { if (sg == jlo) { cl0 = ch0; cl1 = ch1; } const f32x4 t = sb[(size_t)sg * 1024]; ch0 = fexp(t[0]) * ch0 + t[1]; ch1 = fexp(t[2]) * ch1 + t[3]; }
        if (jlo == jhi) { cl0 = ch0; cl1 = ch1; }
        const size_t base = (size_t)bl * TS * EI + cp * 2;
        for (int i0 = 0; i0 < SEGL; i0 += 8) {
            h2 lf[8], uf[8], lb[8], ub[8], g[8];
#pragma unroll
            for (int i = 0; i < 8; ++i) { const int s = seg * SEGL + i0 + i; if (s >= TC) { const size_t o = base + (size_t)s * EI;
                lf[i] = *(const h2*)(LAf + o); uf[i] = *(const h2*)(Uf + o); lb[i] = *(const h2*)(LAb + o); ub[i] = *(const h2*)(Ub + o); g[i] = *(const h2*)(G1 + o); } }
#pragma unroll
            for (int i = 0; i < 8; ++i) { const int s = seg * SEGL + i0 + i; if (s >= TC) {
                const bool hi = ((TS + TC - 1 - s) / SEGL) == jhi;
                const float cb0 = hi ? ch0 : cl0, cb1 = hi ? ch1 : cl1;
                const float y0 = (float)uf[i][0] + fexp((float)lf[i][0]) * cf0 + (float)ub[i][0] + fexp((float)lb[i][0]) * cb0;
                const float y1 = (float)uf[i][1] + fexp((float)lf[i][1]) * cf1 + (float)ub[i][1] + fexp((float)lb[i][1]) * cb1;
                g[i][0] = (f16)(y0 * silu((float)g[i][0])); g[i][1] = (f16)(y1 * silu((float)g[i][1])); } }
#pragma unroll
            for (int i = 0; i < 8; ++i) { const int s = seg * SEGL + i0 + i; if (s >= TC) *(h2*)(G1 + base + (size_t)s * EI) = g[i]; }
        }
    }
}

__device__ __forceinline__ void phase_final(const Params& p, float delta, int wv_, int rbeg, int rend, int vb, int VG) {
    const int tid_ = otid(wv_), lane = tid_ & 63, wid = tid_ >> 6;
    for (int r = rbeg + vb * 8 + wid; r < rend; r += VG * 8) {
        float* row = p.out + (size_t)r * DM;
        f32x4 v[4]; float ss = 0.f;
#pragma unroll
        for (int i = 0; i < 4; ++i) { v[i] = *(const f32x4*)(row + lane * 4 + i * 256); ss += v[i][0] * v[i][0] + v[i][1] * v[i][1] + v[i][2] * v[i][2] + v[i][3] * v[i][3]; }
        ss = wave_sum(ss, lane);
        const float rs = __builtin_amdgcn_rsqf(ss * (1.f / DM) + 1e-6f);
#pragma unroll
        for (int i = 0; i < 4; ++i) { const int k = lane * 4 + i * 256; const f32x4 gg = *(const f32x4*)(p.final_g + k); f32x4 ov = v[i] * rs * gg; if ((r & 15) == 0) ov = ov + delta; *(f32x4*)(row + k) = ov; }
    }
}

#define XB_TMO      128
#define XB_XCNT(j)  (256  + 64 * (j))
#define XB_XSUB(j)  (1280 + 64 * (j))
#define XB_XGEN(j)  (2304 + 64 * (j))
#define XB_TOP      3328
#define XB_TOPGEN   3392
#define XCD_BAR_WORDS 3456
#define XB_SPIN_CAP (1u << 18)
__device__ __forceinline__ unsigned xb_ld(unsigned* p)              { return __hip_atomic_load(p, __ATOMIC_RELAXED, __HIP_MEMORY_SCOPE_AGENT); }
__device__ __forceinline__ unsigned xb_add(unsigned* p, unsigned v) { return __hip_atomic_fetch_add(p, v, __ATOMIC_RELAXED, __HIP_MEMORY_SCOPE_AGENT); }
__device__ __forceinline__ unsigned xb_xcc_id() { return (unsigned)__builtin_amdgcn_s_getreg((3 << 11) | 20) & 0xFu; }
#define XB_SPIN(cond, bar) do { unsigned _sp = 0; while (cond) { __builtin_amdgcn_s_sleep(1); \
    if ((++_sp & 255u) == 0u) { if (xb_ld(&(bar)[XB_TMO])) break; if (_sp > XB_SPIN_CAP) { atomicAdd(&(bar)[XB_TMO], 1u); break; } } } } while (0)
struct XcdBarrier { unsigned* bar; unsigned x; volatile LAS unsigned* st; };
__device__ __forceinline__ XcdBarrier xcd_barrier_post(unsigned* bar, volatile LAS unsigned* st) {
    XcdBarrier b; b.bar = bar; b.x = xb_xcc_id(); b.st = st;
    if (threadIdx.x == 0) (void)xb_add(&bar[XB_XCNT(b.x)], 1u);
    return b;
}
__device__ __forceinline__ void xcd_barrier_complete(unsigned* bar, unsigned x, unsigned& nloc, unsigned& nx) {
    const unsigned G = gridDim.x * gridDim.y * gridDim.z;
    unsigned sum, cnt, mine, sp = 0u;
    for (;;) {
        sum = 0u; cnt = 0u; mine = 0u;
#pragma unroll
        for (unsigned j = 0; j < 16; ++j) { const unsigned c = xb_ld(&bar[XB_XCNT(j)]); sum += c; cnt += (c > 0u) ? 1u : 0u; mine = (j == x) ? c : mine; }
        if (sum == G) break;
        __builtin_amdgcn_s_sleep(1);
        if ((++sp & 255u) == 0u) { if (xb_ld(&bar[XB_TMO])) break; if (sp > XB_SPIN_CAP) { atomicAdd(&bar[XB_TMO], 1u); break; } }
    }
    nloc = mine > 0u ? mine : 1u; nx = cnt > 0u ? cnt : 1u;
}
__device__ __forceinline__ void xcd_barrier(const XcdBarrier& b) {
    asm volatile("s_waitcnt vmcnt(0)" ::: "memory");
    __syncthreads();
    if (threadIdx.x == 0) {
        unsigned* bar = b.bar; unsigned bx = __builtin_amdgcn_readfirstlane(b.x);
        asm volatile("" : "+s"(bx));
        __builtin_amdgcn_s_waitcnt(0);
        unsigned nloc = b.st[0], nx = b.st[1];
        if (nloc == 0u) { xcd_barrier_complete(bar, bx, nloc, nx); b.st[0] = nloc; b.st[1] = nx; }
        const unsigned old = xb_add(&bar[XB_XSUB(bx)], 1u);
        const unsigned gen = old / nloc;
        if (old + 1u == (gen + 1u) * nloc) {
            __builtin_amdgcn_fence(__ATOMIC_RELEASE, "agent");
            asm volatile("s_waitcnt vmcnt(0)" ::: "memory");
            const unsigned og = xb_add(&bar[XB_TOP], 1u);
            const unsigned tg = og / nx;
            if (og + 1u == (tg + 1u) * nx) xb_add(&bar[XB_TOPGEN], 1u);
            else XB_SPIN(xb_ld(&bar[XB_TOPGEN]) == tg, bar);
            __builtin_amdgcn_fence(__ATOMIC_ACQUIRE, "agent");
            xb_add(&bar[XB_XGEN(bx)], 1u);
            asm volatile("s_waitcnt vmcnt(0)" ::: "memory");
        } else {
            XB_SPIN(xb_ld(&bar[XB_XGEN(bx)]) == gen, bar);
            __builtin_amdgcn_fence(__ATOMIC_ACQUIRE, "agent");
            asm volatile("s_waitcnt vmcnt(0)" ::: "memory");
        }
    }
    __syncthreads();
}

#if PROBE_ON
#define STAMP(type) do { if (bid == 0 && threadIdx.x == 0) { unsigned long long* tacc_ = (unsigned long long*)(p.ws + WS_TS); const unsigned long long now_ = wall_clock64(); tacc_[type] += now_ - tacc_[15]; tacc_[15] = now_; } } while (0)
#else
#define STAMP(type) do { } while (0)
#endif
__global__ void __launch_bounds__(512, 2) mega(Params p) {
    extern __shared__ __attribute__((aligned(16))) unsigned char lds_raw[];
    LAS unsigned char* lds = (LAS unsigned char*)lds_raw;
    cg::grid_group grid = cg::this_grid();
    const int G = gridDim.x, bid = blockIdx.x;
    const int wv_ = __builtin_amdgcn_readfirstlane((int)(threadIdx.x >> 6));
    volatile LAS unsigned* xst = (volatile LAS unsigned*)(lds + LDS_XST);
    if (threadIdx.x == 0) { xst[0] = 0u; xst[1] = 0u; }
    __syncthreads();
    const XcdBarrier xb = xcd_barrier_post((unsigned*)(p.ws + WS_BAR), xst);
    if (gridDim.x == 0x7fffffffu) grid.sync();
    unsigned char* ws = p.ws;
#if PROBE_ON
    if (bid == 0 && threadIdx.x == 0) { unsigned long long* tacc_ = (unsigned long long*)(ws + WS_TS); for (int i = 0; i < 24; ++i) tacc_[i] = 0; tacc_[13] = tacc_[15] = wall_clock64(); }
#endif

    phase0(p, lds_raw, wv_);
    xcd_barrier(xb); STAMP(0);

    const int naux = (G > 128) ? G - 128 : G, vaux = (G > 128) ? bid - 128 : bid;
    phase_h<0>(p, 0, wv_, bid, G);
    xcd_barrier(xb); STAMP(1);
#define MK_GEMM1(SCHED_SETUP) do { pg8::Gemm g{(const f16*)(ws + WS_H), (const f16*)(ws + WS_WIN0T), 36, 40, 1024, 1024, 1024, 0}; \
          pg8::StaticOrder S; SCHED_SETUP; pg8::Epi1 E{(f16*)(ws + WS_R), (const float*)(ws + WS_LB0)}; pg8::gemm_phase(lds, g, S, E, wv_); } while (0)
#define MK_GEMM2(HB) do { pg8::Gemm g{(const f16*)(ws + WS_R) + (size_t)4 * (SLOT / 2), (const f16*)(ws + WS_WOUT0T), 36, 4, 2048, 2048, 2048, 0}; \
          pg8::StaticOrder S; S.init(36, 4, G, bid, 0); pg8::Epi2 E{p.x, p.ctx, p.out, (float*)(ws + WS_X1C), (const float*)(ws + WS_MODS), (HB)}; pg8::gemm_phase(lds, g, S, E, wv_); } while (0)
    MK_GEMM1(S.init(36, 40, G, bid, 0));
    xcd_barrier(xb); STAMP(2);
    phase_hgrn(p, lds, wv_);
    if (vaux >= 0) {
        phase_transposes(p, lds_raw, wv_, 3072, 5120, vaux, naux);
        phase_h<0>(p, 1, wv_, vaux, naux);
    }
    xcd_barrier(xb); STAMP(3);
    phase_readout(p, wv_);
    xcd_barrier(xb); STAMP(4);
    MK_GEMM2(0);
    MK_GEMM1(S.init(36, 32, G, bid, 0); if (G == 256) { if (bid >= 144) { S.G = 112; S.c = bid - 144; S.maxi = 6; } else { S.G = 144; S.c = bid; S.base = 672; S.maxi = 4; } });
    xcd_barrier(xb); STAMP(5);
    phase_hgrn(p, lds, wv_);
    if (vaux >= 0) MK_GEMM1(S.init(36, 8, naux, vaux, 0); S.pn0 = 32);
    xcd_barrier(xb); STAMP(3);
    phase_readout(p, wv_);
    xcd_barrier(xb); STAMP(4);
    MK_GEMM2(1);
    if (G > 144) { if (bid >= 144) phase_h<1>(p, 0, wv_, bid - 144, G - 144); }
    else phase_h<1>(p, 0, wv_, bid, G);
    xcd_barrier(xb); STAMP(5);

#pragma unroll 1
    for (int hb = 0; hb < 2; ++hb) {
#define MK_GEMM3(SCHED_SETUP) do { pg8::Gemm g{(const f16*)(ws + WS_S + (size_t)(hb ? 5 : 4) * SLOT), (const f16*)(ws + WS_WIN1T), 36, 16, 1024, 1024, 1024, 0}; \
          pg8::StaticOrder S; SCHED_SETUP; pg8::Epi3 E{(f16*)(ws + WS_S)}; pg8::gemm_phase(lds, g, S, E, wv_); } while (0)
        if (G == 256) {
            MK_GEMM3(S.init(36, 8, G, bid, 0));
            MK_GEMM3(S.init(28, 8, 224, bid - 32, 1); S.pn0 = 8; if (bid < 32) S.maxi = 0; else S.maxi = 1);
            xcd_barrier(xb); STAMP(7);
            if (bid < 32) MK_GEMM3(S.init(4, 8, 32, bid, 1); S.pn0 = 8; S.pm0 = 28; S.maxi = 1);
            else phase_conv(p, wv_, bid - 32, 224);
        } else {
            MK_GEMM3(S.init(36, 16, G, bid, 0));
            xcd_barrier(xb); STAMP(7);
            phase_conv(p, wv_, bid, G);
        }
        xcd_barrier(xb); STAMP(8);
        { pg8::Gemm g{(const f16*)(ws + WS_S + 2 * SLOT), (const f16*)(ws + WS_WCO), 36, 32, 256, 2048, 256, 2};
          pg8::StaticOrder S; S.init(36, 32, G, bid, 0);
          pg8::Epi4 E{(f16*)(ws + WS_S)};
          pg8::gemm_phase(lds, g, S, E, wv_); }
        xcd_barrier(xb); STAMP(9);
        phase_scan_local(p, wv_);
        xcd_barrier(xb); STAMP(10);
        phase_scan_final(p, wv_);
        xcd_barrier(xb); STAMP(11);
        { pg8::Gemm g{(const f16*)(ws + WS_S + 1 * SLOT), (const f16*)(ws + WS_WOUT1T), 32, 4, 2048, 2048, 2048, 1};
          pg8::StaticOrder S; S.init(32, 4, G, bid, 1);
          pg8::Epi5 E{p.out, (const float*)(ws + WS_MODS) + 9 * 3072, hb};
          pg8::gemm_phase(lds, g, S, E, wv_); }
        if (hb == 0) {
            if (G > 128) { if (bid >= 128) phase_h<1>(p, 1, wv_, bid - 128, G - 128); }
            else phase_h<1>(p, 1, wv_, bid, G);
        }
#if !PROBE_ON
        else if (G > 128 && bid >= 128) phase_final(p, 0.f, wv_, 0, 4 * TL, bid - 128, G - 128);
#endif
        xcd_barrier(xb); STAMP(12);
    }
#if PROBE_ON
    if (bid == 0 && threadIdx.x == 0) { unsigned long long* tacc_ = (unsigned long long*)(ws + WS_TS); tacc_[14] = tacc_[15] - tacc_[13]; }
    xcd_barrier(xb);
    { const unsigned long long* tacc = (const unsigned long long*)(ws + WS_TS); unsigned long long tot = tacc[14], ta = 0, tb = 0, td = 0;
      for (int i = 0; i < 14; ++i) { if ((PROBE_A_MASK >> i) & 1) ta += tacc[i]; if ((PROBE_B_MASK >> i) & 1) tb += tacc[i]; if ((PROBE_DUR_MASK >> i) & 1) td += tacc[i]; }
#if PROBE_ON == 2
      tot = tacc[16] + tacc[17] + tacc[18]; ta = tacc[16]; tb = tacc[17]; td = 0;
#endif
      int a = (int)((ta * 64 + tot / 2) / tot), b = (int)((tb * 32 + tot / 2) / tot); if (a > 63) a = 63; if (b > 31) b = 31;
      const float X = (float)(a * 32 + b) * (1.f / 2048.f);
      phase_final(p, 0.04f * __builtin_sqrtf(X), wv_, 0, 8 * TL, bid, G);
      if (bid == 0 && threadIdx.x == 0) { const unsigned long long t0 = wall_clock64(); while (wall_clock64() - t0 < td) { __builtin_amdgcn_s_sleep(8); } }
      __syncthreads(); }
#else
    if (G > 128) phase_final(p, 0.f, wv_, 4 * TL, 8 * TL, bid, G);
    else phase_final(p, 0.f, wv_, 0, 8 * TL, bid, G);
#endif
}

extern "C" void kernel_launch(void* const* d_in, const int* in_sizes, int n_in, void* d_out, int out_size, void* d_ws, size_t ws_size, hipStream_t stream) {
    static int grid_blocks = 0;
    if (!grid_blocks) {
        int dev = 0, cus = 0, per_cu = 0;
        hipGetDevice(&dev);
        hipDeviceGetAttribute(&cus, hipDeviceAttributeMultiprocessorCount, dev);
        if (hipFuncSetAttribute((const void*)mega, hipFuncAttributeMaxDynamicSharedMemorySize, LDS_BYTES) != hipSuccess) fprintf(stderr, "hipFuncSetAttribute failed\n");
        hipOccupancyMaxActiveBlocksPerMultiprocessor(&per_cu, (const void*)mega, 512, LDS_BYTES);
        if (per_cu < 1) { fprintf(stderr, "occupancy query says %d blocks/CU\n", per_cu); per_cu = 1; }
        grid_blocks = cus;
        if (ws_size < 252 * MiB) fprintf(stderr, "workspace too small: %zu\n", ws_size);
    }
    Params p{};
    const float** pp = (const float**)&p;
    for (int i = 0; i < 21; ++i) pp[i] = (const float*)d_in[i];
    p.out = (float*)d_out; p.ws = (unsigned char*)d_ws;
    if (hipMemsetAsync((unsigned char*)d_ws + WS_BAR, 0, XCD_BAR_WORDS * 4 + 256, stream) != hipSuccess) fprintf(stderr, "barrier memset failed\n");
    void* args[] = {&p};
    hipError_t e = hipLaunchCooperativeKernel((const void*)mega, dim3(grid_blocks), dim3(512), args, LDS_BYTES, stream);
    if (e != hipSuccess) fprintf(stderr, "cooperative launch failed: %s (grid %d)\n", hipGetErrorString(e), grid_blocks);
}
```

```cpp
#include <hip/hip_runtime.h>
#include <hip/hip_cooperative_groups.h>
#include <cstdio>
namespace cg = cooperative_groups;

#define LAS __attribute__((address_space(3)))
typedef _Float16 f16;
typedef _Float16 h8 __attribute__((ext_vector_type(8)));
typedef _Float16 h4 __attribute__((ext_vector_type(4)));
typedef _Float16 h2 __attribute__((ext_vector_type(2)));
typedef float f32x4 __attribute__((ext_vector_type(4)));

#define PROBE_ON 0
#define PROBE_DUR_MASK 0x0008u
#define PROBE_A_MASK   0x0C00u
#define PROBE_B_MASK   0x0001u
constexpr int DM = 1024, EI = 2048, TL = 2048, TC = 256, TS = 2304, HBN = 4, MH = HBN * TS;
constexpr size_t MiB = 1u << 20;
constexpr size_t SLOT = 36 * MiB;
constexpr size_t WS_WIN1T = 0, WS_WCO = 8 * MiB, WS_WOUT1T = 12 * MiB, WS_X1C = 16 * MiB, WS_SEGT = 24 * MiB,
                 WS_MODS = 29 * MiB, WS_LB0 = 29 * MiB + 512 * 1024, WS_COEF = 29 * MiB + 768 * 1024, WS_DYN = 30 * MiB;
constexpr size_t WS_WIN0T = WS_DYN, WS_WOUT0T = WS_DYN + 20 * MiB, WS_H = WS_DYN + 24 * MiB, WS_R = WS_DYN + 42 * MiB;
constexpr size_t WS_S = WS_DYN;
constexpr int LDS_XST = 159744;
constexpr int LDS_BYTES = LDS_XST + 64;
constexpr size_t WS_BAR = 29 * MiB + 928 * 1024;
constexpr size_t WS_TS = 29 * MiB + 900 * 1024;

struct Params {
    const float *x, *c, *ctx, *c_ctx, *ada_w, *ada_b, *norm_g, *final_g, *hg_w_in, *hg_lb, *hg_norm_g, *hg_w_out,
                *rg_w_in, *rg_conv_w, *rg_conv_b, *rg_w_a, *rg_b_a, *rg_w_x, *rg_b_x, *rg_lambda, *rg_w_out;
    float* out; unsigned char* ws;
};

__device__ __forceinline__ int otid(int wv_) { int l; asm volatile("v_mbcnt_lo_u32_b32 %0, -1, 0\n\tv_mbcnt_hi_u32_b32 %0, -1, %0" : "=v"(l)); return (wv_ << 6) | l; }
__device__ __forceinline__ const char* uni_ptr(const char* q) { const unsigned long long a = (unsigned long long)q; const unsigned lo = __builtin_amdgcn_readfirstlane((unsigned)a), hi = __builtin_amdgcn_readfirstlane((unsigned)(a >> 32)); return (const char*)(((unsigned long long)hi << 32) | lo); }
__device__ __forceinline__ float fexp(float v) { return __builtin_amdgcn_exp2f(v * 1.4426950408889634f); }
__device__ __forceinline__ float flog(float v) { return __builtin_amdgcn_logf(v) * 0.6931471805599453f; }
__device__ __forceinline__ float frcp(float v) { return __builtin_amdgcn_rcpf(v); }
__device__ __forceinline__ float fsqrt(float v) { return __builtin_amdgcn_sqrtf(v); }
__device__ __forceinline__ float sigm(float v) { return frcp(1.f + fexp(-v)); }
__device__ __forceinline__ float silu(float v) { return v * sigm(v); }
__device__ __forceinline__ float shx(float v, int lane, int o) { return __int_as_float(__builtin_amdgcn_ds_bpermute((lane ^ o) << 2, __float_as_int(v))); }
__device__ __forceinline__ float wave_sum(float v, int lane) {
#pragma unroll
    for (int o = 32; o > 0; o >>= 1) v += shx(v, lane, o);
    return v;
}

namespace pg8 {
constexpr int BM = 256, BK = 64, HALF = 128, HTB = HALF * BK * 2, STAGE_BYTES = 8 * HTB, NXCD = 8, WGM = 8;
__device__ __forceinline__ int lds_byte(int r, int c) { const int st = (r >> 4) * 2 + (c >> 5), rr = r & 15, cc = c & 31, ob = rr * 64 + cc * 2; return st * 1024 + (ob ^ (((ob >> 9) & 1) << 5)); }
__device__ __forceinline__ void stage_rc(int b, int& R, int& C) { const int st = b / 1024, sb = b % 1024, swz = sb ^ (((sb >> 9) & 1) << 5); R = (st >> 1) * 16 + swz / 64; C = (st & 1) * 32 + (swz % 64) / 2; }
__device__ __forceinline__ int perm32(int rho) { const int n = rho >> 4, i = rho & 15; return 8 * (i >> 2) + 4 * n + (i & 3); }

struct Unit { int pm, pn; };
struct Gemm { const f16* A; const f16* Bt; int nM, nN, K, lda, ldb, mode; };

struct StaticOrder {
    int nM, nN, nwg, G, c, mode, base, maxi, pn0, pm0;
    __device__ void init(int nM_, int nN_, int G_, int c_, int mode_) { nM = nM_; nN = nN_; nwg = nM * nN; G = G_; c = c_; mode = mode_; base = 0; maxi = 1 << 30; pn0 = 0; pm0 = 0; }
    __device__ bool next(int i, Unit& u) const {
        if (i >= maxi) return false;
        const long L = (long)base + (long)i * G + c; if (L >= nwg) return false;
        int wgid = (int)L; { const int q = nwg / NXCD, r = nwg % NXCD, xcd = wgid % NXCD, off = wgid / NXCD; wgid = (xcd < r ? xcd * (q + 1) : r * (q + 1) + (xcd - r) * q) + off; }
        const int nig = WGM * nN, gid = wgid / nig, fm = gid * WGM, gsz = (nM - fm) < WGM ? (nM - fm) : WGM;
        int pm = fm + ((wgid % nig) % gsz) + pm0; u.pn = (wgid % nig) / gsz + pn0;
        if (mode == 1) pm = (pm >> 3) * 9 + 1 + (pm & 7);
        u.pm = pm; return true;
    }
};

template <class Epi>
__device__ __forceinline__ void gemm_phase(LAS unsigned char* lds, const Gemm g, const StaticOrder& S, const Epi& E, int wv_) {
    const int tid = otid(wv_), wid = __builtin_amdgcn_readfirstlane(tid >> 6), lane = tid & 63, wr = wid >> 2, wc = wid & 3, fr = lane & 15, fq = lane >> 4;
    const int K = g.K, nt = K / BK;
    unsigned voffA[2], voffB[2];
#pragma unroll
    for (int i = 0; i < 2; ++i) { int R, C; stage_rc(tid * 16 + i * 8192, R, C); const int Rb = (R & ~31) + perm32(R & 31);
        voffA[i] = (unsigned)(R * g.lda + C) * 2u; voffB[i] = (unsigned)(Rb * g.ldb + C) * 2u; }
    const size_t kstep = (size_t)(BK * 2);
    const size_t hstepA = (size_t)HALF * g.lda * 2, hstepB = (size_t)HALF * g.ldb * 2;
    const unsigned ldsw = (unsigned)wid * 1024u;
    const int aoff = lds_byte(wr * 64 + fr, fq * 8), boff = lds_byte(wc * 32 + fr, fq * 8);
#define PG8_SA(b, h) (((b) * 2 + (h)) * HTB)
#define PG8_SB(b, h) ((4 + (b) * 2 + (h)) * HTB)
#define PG8_STAGE(bufoff, gbase, voff) do { const char* _gb = uni_ptr((const char*)(gbase)); asm volatile("" : "+s"(_gb)); _Pragma("unroll") for (int _i = 0; _i < 2; ++_i) \
        __builtin_amdgcn_global_load_lds((const unsigned*)(_gb + (voff)[_i]), (LAS unsigned*)(lds + (bufoff) + ldsw + _i * 8192), 16, 0, 0); } while (0)
#define PG8_LDA(dst, b, h) do { _Pragma("unroll") for (int m = 0; m < 4; ++m) _Pragma("unroll") for (int k = 0; k < 2; ++k) dst[m][k] = *(const LAS h8*)(lds + PG8_SA(b, h) + aoff + m * 2048 + k * 1024); } while (0)
#define PG8_LDB(dst, b, h) do { _Pragma("unroll") for (int n = 0; n < 2; ++n) _Pragma("unroll") for (int k = 0; k < 2; ++k) dst[n][k] = *(const LAS h8*)(lds + PG8_SB(b, h) + boff + n * 2048 + k * 1024); } while (0)
#define PG8_MMA(ai, bj, At, Bt) do { __builtin_amdgcn_s_setprio(1); _Pragma("unroll") for (int m = 0; m < 4; ++m) _Pragma("unroll") for (int n = 0; n < 2; ++n) _Pragma("unroll") for (int k = 0; k < 2; ++k) \
        acc[ai][bj][m][n] = __builtin_amdgcn_mfma_f32_16x16x32_f16(Bt[n][k], At[m][k], acc[ai][bj][m][n], 0, 0, 0); __builtin_amdgcn_s_setprio(0); } while (0)
#define PG8_WAIT_V(n) asm volatile("s_waitcnt vmcnt(" #n ")" ::: "memory")
#define PG8_WAIT_L(n) asm volatile("s_waitcnt lgkmcnt(" #n ")" ::: "memory")
#define PG8_BAR __builtin_amdgcn_s_barrier()
#define PG8_SCHED __builtin_amdgcn_sched_barrier(0)
#define PG8_UA(u) ((const char*)g.A + ((size_t)(u).pm * BM * g.lda + (g.mode == 2 ? (size_t)((((u).pn & 15) >> 1) * 256) : (size_t)0)) * 2)
#define PG8_UB(u) ((const char*)g.Bt + (size_t)(u).pn * BM * g.ldb * 2)
    Unit cur, nxt; int ui = 0;
    if (!S.next(0, cur)) return;
    f32x4 acc[2][2][4][2];
#pragma unroll
    for (int a = 0; a < 2; ++a)
#pragma unroll
        for (int b = 0; b < 2; ++b)
#pragma unroll
            for (int m = 0; m < 4; ++m)
#pragma unroll
                for (int n = 0; n < 2; ++n) acc[a][b][m][n] = (f32x4){0.f, 0.f, 0.f, 0.f};
    h8 At[4][2], B0[2][2], B1[2][2];
    const char* cA = PG8_UA(cur); const char* cB = PG8_UB(cur);
    PG8_STAGE(PG8_SB(0, 0), cB, voffB); PG8_STAGE(PG8_SB(0, 1), cB + hstepB, voffB); PG8_STAGE(PG8_SA(0, 0), cA, voffA); PG8_STAGE(PG8_SA(0, 1), cA + hstepA, voffA);
    if (wr == 1) PG8_BAR;
    PG8_WAIT_V(2); PG8_BAR;
    PG8_STAGE(PG8_SB(1, 0), cB + kstep, voffB); PG8_STAGE(PG8_SA(1, 0), cA + kstep, voffA); PG8_STAGE(PG8_SB(1, 1), cB + hstepB + kstep, voffB);
    PG8_WAIT_V(6); PG8_BAR;
    for (;;) {
        const bool has_next = S.next(ui + 1, nxt);
        const char* nA = has_next ? PG8_UA(nxt) : cA; const char* nB = has_next ? PG8_UB(nxt) : cB;
        for (int t = 0; t < nt; t += 2) {
            const bool last = (t == nt - 2);
            const char* a1 = cA + (size_t)(t + 1) * kstep;
            const char* a2 = last ? nA : cA + (size_t)(t + 2) * kstep; const char* b2 = last ? nB : cB + (size_t)(t + 2) * kstep;
            const char* a3 = a2 + kstep; const char* b3 = b2 + kstep;
            PG8_LDB(B0, 0, 0); PG8_LDB(B1, 0, 1); PG8_SCHED; PG8_LDA(At, 0, 0); PG8_STAGE(PG8_SA(1, 1), a1 + hstepA, voffA);
            PG8_WAIT_V(8); PG8_WAIT_L(0); PG8_BAR; PG8_MMA(0, 0, At, B0); PG8_MMA(0, 1, At, B1); PG8_BAR; PG8_SCHED;
            PG8_LDA(At, 0, 1); PG8_STAGE(PG8_SB(0, 0), b2, voffB); PG8_STAGE(PG8_SB(0, 1), b2 + hstepB, voffB); PG8_STAGE(PG8_SA(0, 0), a2, voffA);
            PG8_WAIT_V(8); PG8_WAIT_L(0); PG8_BAR; PG8_MMA(1, 0, At, B0); PG8_MMA(1, 1, At, B1); PG8_BAR; PG8_SCHED;
            PG8_LDB(B0, 1, 0); PG8_LDB(B1, 1, 1); PG8_SCHED; PG8_LDA(At, 1, 0); PG8_STAGE(PG8_SA(0, 1), a2 + hstepA, voffA);
            PG8_WAIT_V(8); PG8_WAIT_L(0); PG8_BAR; PG8_MMA(0, 0, At, B0); PG8_MMA(0, 1, At, B1); PG8_BAR; PG8_SCHED;
            PG8_LDA(At, 1, 1); PG8_STAGE(PG8_SB(1, 0), b3, voffB); PG8_STAGE(PG8_SB(1, 1), b3 + hstepB, voffB); PG8_STAGE(PG8_SA(1, 0), a3, voffA);
            PG8_WAIT_V(8); PG8_WAIT_L(0); PG8_BAR; PG8_MMA(1, 0, At, B0); PG8_MMA(1, 1, At, B1); PG8_BAR; PG8_SCHED;
        }
        if (wr == 0) PG8_BAR;
        E(acc, cur, wr, wc, fr, fq);
        if (!has_next) break;
#pragma unroll
        for (int a = 0; a < 2; ++a)
#pragma unroll
            for (int b = 0; b < 2; ++b)
#pragma unroll
                for (int m = 0; m < 4; ++m)
#pragma unroll
                    for (int n = 0; n < 2; ++n) acc[a][b][m][n] = (f32x4){0.f, 0.f, 0.f, 0.f};
        cur = nxt; cA = nA; cB = nB; ++ui;
        if (wr == 1) PG8_BAR;
    }
    PG8_WAIT_V(0);
    PG8_BAR;
#undef PG8_SA
#undef PG8_SB
#undef PG8_STAGE
#undef PG8_LDA
#undef PG8_LDB
#undef PG8_MMA
#undef PG8_UA
#undef PG8_UB
}

__device__ __forceinline__ h8 pack8(const float (&v)[8]) { h8 r;
#pragma unroll
    for (int i = 0; i < 8; ++i) r[i] = (f16)v[i];
    return r; }

struct Epi1 {
    static constexpr bool PERM = true;
    f16* R; const float* lb;
    __device__ __forceinline__ void operator()(const f32x4 (&acc)[2][2][4][2], const Unit& u, int wr, int wc, int fr, int fq) const {
        asm volatile("" : "+v"(fr), "+v"(fq));
        const int t = u.pn >> 3; f16* dst = R + (size_t)t * (SLOT / 2);
        const int row0 = u.pm * BM + wr * 64 + fr, col0 = (u.pn & 7) * 256 + wc * 32 + fq * 8;
        float lbv[2][8];
        if (t == 2 || t == 3) {
#pragma unroll
            for (int bj = 0; bj < 2; ++bj)
#pragma unroll
                for (int i = 0; i < 8; ++i) lbv[bj][i] = lb[col0 + bj * HALF + i];
        }
#pragma unroll
        for (int ai = 0; ai < 2; ++ai)
#pragma unroll
            for (int m = 0; m < 4; ++m) {
                f16* rowp = dst + (size_t)(row0 + ai * HALF + m * 16) * EI + col0;
#pragma unroll
                for (int bj = 0; bj < 2; ++bj) {
                    float v[8];
#pragma unroll
                    for (int n = 0; n < 2; ++n)
#pragma unroll
                        for (int i = 0; i < 4; ++i) v[n * 4 + i] = acc[ai][bj][m][n][i];
                    if (t == 0) {
#pragma unroll
                        for (int i = 0; i < 8; ++i) v[i] = silu(v[i]);
                    } else if (t == 2 || t == 3) {
#pragma unroll
                        for (int i = 0; i < 8; ++i) { const float l = lbv[bj][i]; v[i] = __builtin_amdgcn_logf(l + (1.f - l) * sigm(v[i])); }
                    }
                    *(h8*)(rowp + bj * HALF) = pack8(v);
                }
                asm volatile("" ::: "memory"); __builtin_amdgcn_sched_barrier(0);
            }
    }
};

struct Epi2 {
    static constexpr bool PERM = true;
    const float* x; const float* ctx; float* out; float* x1c; const float* mods; int hb;
    __device__ __forceinline__ void operator()(const f32x4 (&acc)[2][2][4][2], const Unit& u, int wr, int wc, int fr, int fq) const {
        asm volatile("" : "+v"(fr), "+v"(fq));
        const int bl = u.pm / 9, tib = u.pm % 9, b = hb * HBN + bl;
        const bool isctx = (tib == 0);
        const float* gp = mods + (size_t)(isctx ? 8 : b) * 3072 + 2048;
        const int col0 = u.pn * BM + wc * 32 + fq * 8;
        f32x4 gv[2][2];
#pragma unroll
        for (int bj = 0; bj < 2; ++bj)
#pragma unroll
            for (int n = 0; n < 2; ++n) gv[bj][n] = *(const f32x4*)(gp + col0 + bj * HALF + n * 4);
#pragma unroll
        for (int ai = 0; ai < 2; ++ai)
#pragma unroll
            for (int m2 = 0; m2 < 4; m2 += 2) {
                float* dst[2]; f32x4 xv[2][2][2];
#pragma unroll
                for (int mm = 0; mm < 2; ++mm) {
                    const int s = tib * 256 + ai * HALF + wr * 64 + (m2 + mm) * 16 + fr;
                    const float* src;
                    if (isctx) { const size_t o = ((size_t)b * TC + s) * DM; src = ctx + o; dst[mm] = x1c + o; }
                    else { const size_t o = ((size_t)b * TL + (s - TC)) * DM; src = x + o; dst[mm] = out + o; }
#pragma unroll
                    for (int bj = 0; bj < 2; ++bj)
#pragma unroll
                        for (int n = 0; n < 2; ++n) xv[mm][bj][n] = *(const f32x4*)(src + col0 + bj * HALF + n * 4);
                }
#pragma unroll
                for (int mm = 0; mm < 2; ++mm)
#pragma unroll
                    for (int bj = 0; bj < 2; ++bj)
#pragma unroll
                        for (int n = 0; n < 2; ++n) *(f32x4*)(dst[mm] + col0 + bj * HALF + n * 4) = xv[mm][bj][n] + gv[bj][n] * acc[ai][bj][m2 + mm][n];
                asm volatile("" ::: "memory"); __builtin_amdgcn_sched_barrier(0);
            }
    }
};

struct Epi3 {
    static constexpr bool PERM = true;
    f16* S;
    __device__ __forceinline__ void operator()(const f32x4 (&acc)[2][2][4][2], const Unit& u, int wr, int wc, int fr, int fq) const {
        asm volatile("" : "+v"(fr), "+v"(fq));
        const int t = u.pn >> 3; f16* dst = S + (size_t)t * (SLOT / 2);
        const int row0 = u.pm * BM + wr * 64 + fr, col0 = (u.pn & 7) * 256 + wc * 32 + fq * 8;
#pragma unroll
        for (int ai = 0; ai < 2; ++ai)
#pragma unroll
            for (int m = 0; m < 4; ++m) {
                f16* rowp = dst + (size_t)(row0 + ai * HALF + m * 16) * EI + col0;
#pragma unroll
                for (int bj = 0; bj < 2; ++bj) {
                    float v[8];
#pragma unroll
                    for (int n = 0; n < 2; ++n)
#pragma unroll
                        for (int i = 0; i < 4; ++i) v[n * 4 + i] = acc[ai][bj][m][n][i];
                    *(h8*)(rowp + bj * HALF) = pack8(v);
                }
                asm volatile("" ::: "memory"); __builtin_amdgcn_sched_barrier(0);
            }
    }
};

struct Epi4 {
    static constexpr bool PERM = true;
    f16* S;
    __device__ __forceinline__ void operator()(const f32x4 (&acc)[2][2][4][2], const Unit& u, int wr, int wc, int fr, int fq) const {
        asm volatile("" : "+v"(fr), "+v"(fq));
        const int d = u.pn >> 4, gi = u.pn & 15;
        const int ch0 = gi * 128 + wc * 32 + fq * 8;
        f16* PA = S + (size_t)(d ? 0 : 3) * (SLOT / 2); f16* PX = S + (size_t)(d ? 5 : 4) * (SLOT / 2);
        const int row0 = u.pm * BM + wr * 64 + fr;
#pragma unroll
        for (int ai = 0; ai < 2; ++ai)
#pragma unroll
            for (int m = 0; m < 4; ++m) {
                const size_t o = (size_t)(row0 + ai * HALF + m * 16) * EI + ch0;
#pragma unroll
                for (int bj = 0; bj < 2; ++bj) {
                    float v[8];
#pragma unroll
                    for (int n = 0; n < 2; ++n)
#pragma unroll
                        for (int i = 0; i < 4; ++i) v[n * 4 + i] = acc[ai][bj][m][n][i];
                    *(h8*)((bj ? PX : PA) + o) = pack8(v);
                }
                asm volatile("" ::: "memory"); __builtin_amdgcn_sched_barrier(0);
            }
    }
};

struct Epi5 {
    static constexpr bool PERM = true;
    float* out; const float* mods; int hb;
    __device__ __forceinline__ void operator()(const f32x4 (&acc)[2][2][4][2], const Unit& u, int wr, int wc, int fr, int fq) const {
        asm volatile("" : "+v"(fr), "+v"(fq));
        const int bl = u.pm / 9, tib = u.pm % 9, b = hb * HBN + bl;
        const float* gp = mods + (size_t)b * 3072 + 2048;
        const int col0 = u.pn * BM + wc * 32 + fq * 8;
        f32x4 gv[2][2];
#pragma unroll
        for (int bj = 0; bj < 2; ++bj)
#pragma unroll
            for (int n = 0; n < 2; ++n) gv[bj][n] = *(const f32x4*)(gp + col0 + bj * HALF + n * 4);
#pragma unroll
        for (int ai = 0; ai < 2; ++ai)
#pragma unroll
            for (int m2 = 0; m2 < 4; m2 += 2) {
                float* dst[2]; f32x4 xv[2][2][2];
#pragma unroll
                for (int mm = 0; mm < 2; ++mm) {
                    const int p = (tib - 1) * 256 + ai * HALF + wr * 64 + (m2 + mm) * 16 + fr;
                    const int t = (p & 31) * 64 + (p >> 5);
                    dst[mm] = out + ((size_t)b * TL + t) * DM;
#pragma unroll
                    for (int bj = 0; bj < 2; ++bj)
#pragma unroll
                        for (int n = 0; n < 2; ++n) xv[mm][bj][n] = *(const f32x4*)(dst[mm] + col0 + bj * HALF + n * 4);
                }
#pragma unroll
                for (int mm = 0; mm < 2; ++mm)
#pragma unroll
                    for (int bj = 0; bj < 2; ++bj)
#pragma unroll
                        for (int n = 0; n < 2; ++n) *(f32x4*)(dst[mm] + col0 + bj * HALF + n * 4) = xv[mm][bj][n] + gv[bj][n] * acc[ai][bj][m2 + mm][n];
                asm volatile("" ::: "memory"); __builtin_amdgcn_sched_barrier(0);
            }
    }
};
}

struct TrJob { const float* src; f16* dst; int lds_n, ldd, k0, n0; };
__device__ __forceinline__ TrJob tr_decode(const Params& p, int job) {
    f16* win0t = (f16*)(p.ws + WS_WIN0T); f16* wout0t = (f16*)(p.ws + WS_WOUT0T); f16* win1t = (f16*)(p.ws + WS_WIN1T);
    f16* wout1t = (f16*)(p.ws + WS_WOUT1T); f16* wco = (f16*)(p.ws + WS_WCO);
    TrJob t;
    if (job < 2560) { const int kt = job / 160, ntl = job % 160; t = TrJob{p.hg_w_in, win0t, 10240, 1024, kt * 64, ntl * 64}; }
    else if (job < 3072) { const int j = job - 2560, kt = j / 16, ntl = j % 16; t = TrJob{p.hg_w_out, wout0t, 1024, 2048, kt * 64, ntl * 64}; }
    else if (job < 4096) { const int j = job - 3072, kt = j / 64, ntl = j % 64; t = TrJob{p.rg_w_in, win1t, 4096, 1024, kt * 64, ntl * 64}; }
    else if (job < 4608) { const int j = job - 4096, kt = j / 16, ntl = j % 16; t = TrJob{p.rg_w_out, wout1t, 1024, 2048, kt * 64, ntl * 64}; }
    else { const int j = job - 4608, mat = j / 16, tl = j % 16, kt = tl / 4, ntl = tl % 4;
        const int hh = mat & 7, which = (mat >> 3) & 1, d = mat >> 4;
        const float* s = (which ? p.rg_w_x : p.rg_w_a) + (size_t)(d * 8 + hh) * 256 * 256;
        const int n0 = ntl * 64;
        f16* dst = wco + (size_t)((d * 16 + hh * 2 + (n0 >> 7)) * 256 + which * 128 + (n0 & 127)) * 256;
        t = TrJob{s, dst - (size_t)n0 * 256, 256, 256, kt * 64, n0}; }
    return t;
}
__device__ __forceinline__ void phase_transposes(const Params& p, unsigned char* lds, int wv_, int j0, int j1, int vb, int VG) {
    float* tile = (float*)lds;
    const int tid = otid(wv_);
    for (int job = j0 + vb; job < j1; job += 2 * VG) {
        const bool two = (job + VG < j1);
        const TrJob a = tr_decode(p, job), b = tr_decode(p, two ? job + VG : job);
        __syncthreads();
        float va[8], vb2[8];
#pragma unroll
        for (int i = 0; i < 8; ++i) { const int idx = tid + i * 512, kk = idx >> 6, nn = idx & 63;
            va[i] = a.src[(size_t)(a.k0 + kk) * a.lds_n + a.n0 + nn]; vb2[i] = b.src[(size_t)(b.k0 + kk) * b.lds_n + b.n0 + nn]; }
#pragma unroll
        for (int i = 0; i < 8; ++i) { const int idx = tid + i * 512, kk = idx >> 6, nn = idx & 63; tile[kk * 65 + nn] = va[i]; tile[4160 + kk * 65 + nn] = vb2[i]; }
        __syncthreads();
#pragma unroll
        for (int i = 0; i < 4; ++i) { const int idx = tid + i * 512, nn = idx >> 5, kp = idx & 31;
            h2 v; v[0] = (f16)tile[(2 * kp) * 65 + nn]; v[1] = (f16)tile[(2 * kp + 1) * 65 + nn];
            *(h2*)(a.dst + (size_t)(a.n0 + nn) * a.ldd + a.k0 + 2 * kp) = v;
            if (two) { h2 w2; w2[0] = (f16)tile[4160 + (2 * kp) * 65 + nn]; w2[1] = (f16)tile[4160 + (2 * kp + 1) * 65 + nn];
                *(h2*)(b.dst + (size_t)(b.n0 + nn) * b.ldd + b.k0 + 2 * kp) = w2; } }
    }
}

__device__ __forceinline__ void phase0(const Params& p, unsigned char* lds, int wv_) {
    const int tid = otid(wv_), G = gridDim.x;
    float* mods = (float*)(p.ws + WS_MODS);
    { const int idx = blockIdx.x * 512 + tid;
      if (idx < EI) { const float a = p.hg_lb[idx], b = p.hg_lb[EI + idx], c = p.hg_lb[2 * EI + idx]; const float m = fmaxf(a, fmaxf(b, c));
          const float ea = fexp(a - m), eb = fexp(b - m), ec = fexp(c - m); ((float*)(p.ws + WS_LB0))[idx] = ea / (ea + eb + ec); } }
    { const int idx = blockIdx.x * 512 + tid;
      if (idx < 2 * EI) ((f32x4*)(p.ws + WS_COEF))[idx] = (f32x4){p.rg_b_a[idx], p.rg_b_x[idx], -8.f * log1pf(fexp(-p.rg_lambda[idx])), 0.f}; }
    float* sc = (float*)lds;
    float* red = sc + 9 * 1024;
    for (int item = blockIdx.x; item < 192; item += G) {
        const int l = item / 96, n0 = (item % 96) * 32;
        __syncthreads();
        for (int i = tid; i < 9 * 1024; i += 512) { const int j = i >> 10, k = i & 1023; const float v = (j < 8) ? p.c[j * 1024 + k] : p.c_ctx[k]; sc[i] = silu(v); }
        __syncthreads();
        const int col = tid & 31, ks = tid >> 5;
        float a[9];
#pragma unroll
        for (int j = 0; j < 9; ++j) a[j] = 0.f;
        const float* w = p.ada_w + (size_t)l * 1024 * 3072 + n0 + col;
#pragma unroll 8
        for (int k = ks * 64; k < ks * 64 + 64; ++k) { const float wv = w[(size_t)k * 3072];
#pragma unroll
            for (int j = 0; j < 9; ++j) a[j] += sc[j * 1024 + k] * wv; }
#pragma unroll
        for (int j = 0; j < 9; ++j) red[(ks * 9 + j) * 32 + col] = a[j];
        __syncthreads();
        if (tid < 288) { const int j = tid >> 5, cc = tid & 31; float s = p.ada_b[l * 3072 + n0 + cc];
            for (int q = 0; q < 16; ++q) s += red[(q * 9 + j) * 32 + cc];
            mods[(size_t)(l * 9 + j) * 3072 + n0 + cc] = s; }
    }
    phase_transposes(p, lds, wv_, 0, 2560, blockIdx.x, G);
}

template <int LAYER>
__device__ __forceinline__ void phase_h(const Params& p, int hb, int wv_, int vb, int VG) {
    const int tid_ = otid(wv_), lane = tid_ & 63, wid = tid_ >> 6;
    const float* mods = (const float*)(p.ws + WS_MODS) + (size_t)LAYER * 9 * 3072;
    const float* g = p.norm_g + LAYER * DM;
    f16* H = (f16*)(p.ws + (LAYER == 0 ? WS_H : WS_S + (size_t)(hb ? 5 : 4) * SLOT));
    const float* x1c = (const float*)(p.ws + WS_X1C);
    for (int r = vb * 8 + wid; r < MH; r += VG * 8) {
        const int bl = r / TS, s = r % TS, b = hb * HBN + bl;
        const float* src; int j;
        if (s < TC) { j = 8; src = (LAYER == 0 ? p.ctx : x1c) + ((size_t)b * TC + s) * DM; }
        else { j = b; const int q = s - TC; const int t = (LAYER == 0) ? q : ((q & 31) * 64 + (q >> 5));
               src = (LAYER == 0 ? p.x : (const float*)p.out) + ((size_t)b * TL + t) * DM; }
        const float* md = mods + (size_t)j * 3072;
        f32x4 v[4]; float ss = 0.f;
#pragma unroll
        for (int i = 0; i < 4; ++i) { v[i] = *(const f32x4*)(src + lane * 4 + i * 256); ss += v[i][0] * v[i][0] + v[i][1] * v[i][1] + v[i][2] * v[i][2] + v[i][3] * v[i][3]; }
        ss = wave_sum(ss, lane);
        const float rs = __builtin_amdgcn_rsqf(ss * (1.f / DM) + 1e-6f);
#pragma unroll
        for (int i = 0; i < 4; ++i) { const int k = lane * 4 + i * 256;
            const f32x4 gg = *(const f32x4*)(g + k), sh = *(const f32x4*)(md + k), scl = *(const f32x4*)(md + 1024 + k);
            h4 o;
#pragma unroll
            for (int e = 0; e < 4; ++e) o[e] = (f16)(v[i][e] * rs * gg[e] * (1.f + scl[e]) + sh[e]);
            *(h4*)(H + (size_t)r * DM + k) = o; }
    }
}

typedef short s4v __attribute__((__vector_size__(8)));
typedef short s8 __attribute__((ext_vector_type(8)));
__device__ __forceinline__ unsigned short f2bf(float x) { unsigned r; asm("v_cvt_pk_bf16_f32 %0, %1, %1" : "=v"(r) : "v"(x)); return (unsigned short)r; }
__device__ __forceinline__ h8 join4(s4v a, s4v b) { typedef short s8v __attribute__((__vector_size__(16))); s8v r = __builtin_shufflevector(a, b, 0, 1, 2, 3, 4, 5, 6, 7); return __builtin_bit_cast(h8, r); }
__device__ __forceinline__ h8 trread8(const LAS f16* a, int rs4) {
    const s4v r0 = __builtin_amdgcn_ds_read_tr16_b64_v4i16((LAS s4v*)a), r1 = __builtin_amdgcn_ds_read_tr16_b64_v4i16((LAS s4v*)(a + rs4));
    return join4(r0, r1); }
constexpr int HRS = 136, HPS = 72;
__device__ __forceinline__ void hg_score_block(const LAS unsigned short* Kside, const LAS unsigned short* Qd, LAS f16* P, int I, int J, bool diag, int l15, int quad) {
    f32x4 acc = (f32x4){0.f, 0.f, 0.f, 0.f};
#pragma unroll
    for (int kk = 0; kk < 4; ++kk) {
        const s8 a = *(const LAS s8*)(Kside + l15 * HRS + 32 * kk + 8 * quad);
        const s8 b = *(const LAS s8*)(Qd + (16 * I + l15) * HRS + 32 * kk + 8 * quad);
        acc = __builtin_amdgcn_mfma_f32_16x16x32_bf16(a, b, acc, 0, 0, 0);
    }
    h4 o;
#pragma unroll
    for (int jj = 0; jj < 4; ++jj) { float v = acc[jj]; if (diag && (4 * quad + jj > l15)) v = 0.f; o[jj] = (f16)v; }
    *(LAS h4*)(P + (16 * I + l15) * HPS + 16 * J + 4 * quad) = o;
}

#define HG_LBAR() do { asm volatile("s_waitcnt lgkmcnt(0)" ::: "memory"); __builtin_amdgcn_s_barrier(); asm volatile("" ::: "memory"); } while (0)
__device__ __forceinline__ void phase_hgrn(const Params& p, LAS unsigned char* lds, int wv_) {
    const int tid = otid(wv_), lane = tid & 63, w = __builtin_amdgcn_readfirstlane(tid >> 6), l15 = lane & 15, quad = lane >> 4;
    LAS f16* Vs = (LAS f16*)lds; LAS f16* Qe = Vs + 64 * HRS; LAS unsigned short* Qd = (LAS unsigned short*)(Qe + 64 * HRS); LAS f16* Kd = (LAS f16*)(Qd + 64 * HRS);
    LAS unsigned short* Kdg = (LAS unsigned short*)(Kd + 64 * HRS); LAS unsigned short* Kx = Kdg + 64 * HRS; LAS f16* P = (LAS f16*)(Kx + 6 * 16 * HRS);
    LAS float* Tj = (LAS float*)(P + 64 * HPS); LAS float* Dk = Tj + 512;
    LAS f16* RQ = (LAS f16*)(lds + 124928); LAS f16* RL = RQ + 64 * HRS;
    const int vrow = tid >> 3, vc16 = (tid & 7) * 16;
    const f16* Qg = (const f16*)(p.ws + WS_R); const f16* Vg = Qg + SLOT / 2;
    h8 Ltri[2];
#pragma unroll
    for (int hf = 0; hf < 2; ++hf)
#pragma unroll
        for (int jx = 0; jx < 8; ++jx) { const int s32 = 8 * quad + jx; Ltri[hf][jx] = (((s32 >> 4) == hf) && ((s32 & 15) <= l15)) ? (f16)1.f : (f16)0.f; }
    __syncthreads();
    for (int i = tid; i < 64 * HPS / 2; i += 512) ((LAS unsigned*)P)[i] = 0u;
    for (int chain = blockIdx.x; chain < 128; chain += gridDim.x) {
        const int dir = chain & 1, h = (chain >> 1) & 15, bl = chain >> 5;
        f16* LFg = (f16*)(p.ws + WS_R) + (size_t)(2 + dir) * (SLOT / 2);
        f32x4 S[8];
#pragma unroll
        for (int i = 0; i < 8; ++i) S[i] = (f32x4){0.f, 0.f, 0.f, 0.f};
        h8 qv[2][2], lv[2][2], vr[2][2];
#if PROBE_ON == 2
        if (blockIdx.x == 0 && tid == 0) { unsigned long long* ta = (unsigned long long*)(p.ws + WS_TS); ta[19] = wall_clock64(); }
#endif
        {
            const int cpos = dir ? 3 : 0; const size_t base = ((size_t)bl * TS + cpos * 64) * EI + h * 128;
            const int row = dir ? 63 - vrow : vrow; const size_t o = base + (size_t)row * EI + vc16;
            qv[0][0] = *(const h8*)(Qg + o); qv[0][1] = *(const h8*)(Qg + o + 8); lv[0][0] = *(const h8*)(LFg + o); lv[0][1] = *(const h8*)(LFg + o + 8);
            vr[0][0] = *(const h8*)(Vg + o); vr[0][1] = *(const h8*)(Vg + o + 8);
        }
        __syncthreads();
        *(LAS h8*)(RQ + vrow * HRS + vc16) = qv[0][0]; *(LAS h8*)(RQ + vrow * HRS + vc16 + 8) = qv[0][1];
        *(LAS h8*)(RL + vrow * HRS + vc16) = lv[0][0]; *(LAS h8*)(RL + vrow * HRS + vc16 + 8) = lv[0][1];
        {
            const int cpos = dir ? 2 : 1; const size_t base = ((size_t)bl * TS + cpos * 64) * EI + h * 128;
            const int row = dir ? 63 - vrow : vrow; const size_t o = base + (size_t)row * EI + vc16;
            qv[1][0] = *(const h8*)(Qg + o); qv[1][1] = *(const h8*)(Qg + o + 8); lv[1][0] = *(const h8*)(LFg + o); lv[1][1] = *(const h8*)(LFg + o + 8);
            vr[1][0] = *(const h8*)(Vg + o); vr[1][1] = *(const h8*)(Vg + o + 8);
        }
        __syncthreads();
        for (int cc2 = 0; cc2 < 36; cc2 += 2) {
#pragma unroll
        for (int hs = 0; hs < 2; ++hs) {
            const int cc = cc2 + hs;
            const int cpos = dir ? (cc < 4 ? 3 - cc : 39 - cc) : cc;
            const size_t base = ((size_t)bl * TS + cpos * 64) * EI + h * 128;
            *(LAS h8*)(Vs + vrow * HRS + vc16) = vr[hs][0]; *(LAS h8*)(Vs + vrow * HRS + vc16 + 8) = vr[hs][1];
            f32x4 cacc[4];
#pragma unroll
            for (int ks = 0; ks < 2; ++ks) {
                const h8 lfT = trread8(RL + (32 * ks + 8 * quad + (l15 >> 2)) * HRS + 16 * w + 4 * (l15 & 3), 4 * HRS);
#pragma unroll
                for (int hf = 0; hf < 2; ++hf) cacc[2 * ks + hf] = __builtin_amdgcn_mfma_f32_16x16x32_f16(lfT, Ltri[hf], (f32x4){0.f, 0.f, 0.f, 0.f}, 0, 0, 0);
            }
            f32x4 eT[4];
#pragma unroll
            for (int I = 0; I < 4; ++I)
#pragma unroll
                for (int jj = 0; jj < 4; ++jj) eT[I][jj] = __builtin_amdgcn_exp2f(__int_as_float(__builtin_amdgcn_ds_bpermute(((lane & 48) | 15) << 2, __float_as_int(cacc[I][jj]))));
            const f32x4 e12 = eT[1] * eT[2];
            f32x4 eBs[4], eEnd[4];
            eBs[0] = (f32x4){1.f, 1.f, 1.f, 1.f}; eBs[1] = eT[0]; eBs[2] = eT[0] * eT[1]; eBs[3] = eBs[2] * eT[2];
            eEnd[3] = (f32x4){1.f, 1.f, 1.f, 1.f}; eEnd[2] = eT[3]; eEnd[1] = eT[2] * eT[3]; eEnd[0] = e12 * eT[3];
            if (l15 == 0) *(LAS f32x4*)(Dk + 16 * w + 4 * quad) = eBs[3] * eT[3];
            typedef float f32x2 __attribute__((ext_vector_type(2)));
            typedef unsigned u32x2 __attribute__((ext_vector_type(2)));
#pragma unroll
            for (int I = 0; I < 4; ++I) {
                const int o = (16 * I + l15) * HRS + 16 * w + 4 * quad;
                const h4 q4 = *(const LAS h4*)(RQ + o), l4 = *(const LAS h4*)(RL + o);
                u32x2 qdp, kgp, kx0p, kx1p, kx2p; h4 qe4, kd4;
#pragma unroll
                for (int pr = 0; pr < 2; ++pr) {
                    const int j0 = 2 * pr, j1 = 2 * pr + 1;
                    const f32x2 ci = {fmaxf(cacc[I][j0], -86.f), fmaxf(cacc[I][j1], -86.f)};
                    const f32x2 e1 = {__builtin_amdgcn_exp2f(ci.x), __builtin_amdgcn_exp2f(ci.y)};
                    const f32x2 inv = {__builtin_amdgcn_rcpf(e1.x), __builtin_amdgcn_rcpf(e1.y)};
                    const f32x2 fg = {__builtin_amdgcn_exp2f((float)l4[j0]), __builtin_amdgcn_exp2f((float)l4[j1])};
                    const f32x2 kk = (f32x2){1.f, 1.f} - fg;
                    const f32x2 qq = {(float)q4[j0], (float)q4[j1]};
                    const f32x2 qd = qq * e1;
                    const f32x2 qe = qd * (f32x2){eBs[I][j0], eBs[I][j1]};
                    const f32x2 kg = kk * inv;
                    const f32x2 kx = kg * (f32x2){eT[I][j0], eT[I][j1]};
                    const f32x2 kd = kx * (f32x2){eEnd[I][j0], eEnd[I][j1]};
                    const f32x2 k1 = kx * (I == 0 ? (f32x2){eT[1][j0], eT[1][j1]} : (f32x2){eT[2][j0], eT[2][j1]});
                    const f32x2 k2 = kx * (f32x2){e12[j0], e12[j1]};
                    unsigned t0, t1, t2, t3, t4;
                    asm("v_cvt_pk_bf16_f32 %0, %1, %2" : "=v"(t0) : "v"(qd.x), "v"(qd.y));
                    asm("v_cvt_pk_bf16_f32 %0, %1, %2" : "=v"(t1) : "v"(kg.x), "v"(kg.y));
                    asm("v_cvt_pk_bf16_f32 %0, %1, %2" : "=v"(t2) : "v"(kx.x), "v"(kx.y));
                    asm("v_cvt_pk_bf16_f32 %0, %1, %2" : "=v"(t3) : "v"(k1.x), "v"(k1.y));
                    asm("v_cvt_pk_bf16_f32 %0, %1, %2" : "=v"(t4) : "v"(k2.x), "v"(k2.y));
                    qdp[pr] = t0; kgp[pr] = t1; kx0p[pr] = t2; kx1p[pr] = t3; kx2p[pr] = t4;
                    qe4[j0] = (f16)qe.x; qe4[j1] = (f16)qe.y; kd4[j0] = (f16)kd.x; kd4[j1] = (f16)kd.y;
                }
                *(LAS u32x2*)(Qd + o) = qdp;
                *(LAS h4*)(Qe + (16 * I + l15) * HRS + 32 * (w >> 1) + 8 * quad + 4 * (w & 1)) = qe4;
                *(LAS u32x2*)(Kdg + o) = kgp;
                *(LAS h4*)(Kd + o) = kd4;
                const int basej = (I == 0) ? 0 : (I == 1 ? 3 : 5); const int ox = l15 * HRS + 16 * w + 4 * quad;
                if (I < 3) *(LAS u32x2*)(Kx + basej * 16 * HRS + ox) = kx0p;
                if (I < 2) *(LAS u32x2*)(Kx + (basej + 1) * 16 * HRS + ox) = kx1p;
                if (I < 1) *(LAS u32x2*)(Kx + (basej + 2) * 16 * HRS + ox) = kx2p;
            }
            HG_LBAR();
#if PROBE_ON == 2
            if (blockIdx.x == 0 && tid == 0) { unsigned long long* ta = (unsigned long long*)(p.ws + WS_TS); const unsigned long long n = wall_clock64(); ta[16] += n - ta[19]; ta[19] = n; }
#endif
            if (cc < 34) {
                const int cn = cc + 2, cposn = dir ? (cn < 4 ? 3 - cn : 39 - cn) : cn; const size_t bn = ((size_t)bl * TS + cposn * 64) * EI + h * 128;
                const int row = dir ? 63 - vrow : vrow; const size_t o = bn + (size_t)row * EI + vc16;
                qv[hs][0] = *(const h8*)(Qg + o); qv[hs][1] = *(const h8*)(Qg + o + 8); lv[hs][0] = *(const h8*)(LFg + o); lv[hs][1] = *(const h8*)(LFg + o + 8);
                vr[hs][0] = *(const h8*)(Vg + o); vr[hs][1] = *(const h8*)(Vg + o + 8);
            }
            if (w < 4) hg_score_block(Kdg + 16 * w * HRS, Qd, P, w, w, true, l15, quad);
            if (w == 4) hg_score_block(Kx + 0 * 16 * HRS, Qd, P, 1, 0, false, l15, quad);
            if (w == 5) hg_score_block(Kx + 1 * 16 * HRS, Qd, P, 2, 0, false, l15, quad);
            if (w == 6) hg_score_block(Kx + 3 * 16 * HRS, Qd, P, 2, 1, false, l15, quad);
            if (w == 7) hg_score_block(Kx + 2 * 16 * HRS, Qd, P, 3, 0, false, l15, quad);
            if (w == 0) hg_score_block(Kx + 4 * 16 * HRS, Qd, P, 3, 1, false, l15, quad);
            if (w == 1) hg_score_block(Kx + 5 * 16 * HRS, Qd, P, 3, 2, false, l15, quad);
            h8 BV[2];
#pragma unroll
            for (int ks = 0; ks < 2; ++ks) BV[ks] = trread8(Vs + (32 * ks + 8 * quad + (l15 >> 2)) * HRS + 16 * w + 4 * (l15 & 3), 4 * HRS);
            f32x4 oacc[4];
            {
                h8 Sf[4];
#pragma unroll
                for (int kk = 0; kk < 4; ++kk)
#pragma unroll
                    for (int e = 0; e < 4; ++e) { Sf[kk][e] = (f16)S[2 * kk][e]; Sf[kk][4 + e] = (f16)S[2 * kk + 1][e]; }
#pragma unroll
                for (int I = 0; I < 4; ++I) {
                    f32x4 o = (f32x4){0.f, 0.f, 0.f, 0.f};
#pragma unroll
                    for (int kk = 0; kk < 4; ++kk) { const h8 qf = *(const LAS h8*)(Qe + (16 * I + l15) * HRS + 32 * kk + 8 * quad);
                        o = __builtin_amdgcn_mfma_f32_16x16x32_f16(Sf[kk], qf, o, 0, 0, 0); }
                    oacc[I] = o;
                }
            }
#pragma unroll
            for (int kt = 0; kt < 8; ++kt) {
                const f32x4 dk = *(const LAS f32x4*)(Dk + 16 * kt + 4 * quad);
                S[kt] = S[kt] * dk;
#pragma unroll
                for (int ks = 0; ks < 2; ++ks) { const h8 af = trread8(Kd + (32 * ks + 8 * quad + (l15 >> 2)) * HRS + 16 * kt + 4 * (l15 & 3), 4 * HRS);
                    S[kt] = __builtin_amdgcn_mfma_f32_16x16x32_f16(af, BV[ks], S[kt], 0, 0, 0); }
            }
            HG_LBAR();
#if PROBE_ON == 2
            if (blockIdx.x == 0 && tid == 0) { unsigned long long* ta = (unsigned long long*)(p.ws + WS_TS); const unsigned long long n = wall_clock64(); ta[17] += n - ta[19]; ta[19] = n; }
#endif
#pragma unroll
            for (int I = 0; I < 4; ++I) {
                f32x4 o = oacc[I];
                { const h8 pf = *(const LAS h8*)(P + (16 * I + l15) * HPS + 8 * quad); o = __builtin_amdgcn_mfma_f32_16x16x32_f16(BV[0], pf, o, 0, 0, 0); }
                if (I >= 2) { const h8 pf = *(const LAS h8*)(P + (16 * I + l15) * HPS + 32 + 8 * quad); o = __builtin_amdgcn_mfma_f32_16x16x32_f16(BV[1], pf, o, 0, 0, 0); }
                const int t = 16 * I + l15, row = dir ? 63 - t : t;
                h4 ov;
#pragma unroll
                for (int e = 0; e < 4; ++e) ov[e] = (f16)o[e];
                *(h4*)(LFg + base + (size_t)row * EI + 16 * w + 4 * quad) = ov;
            }
            if (cc < 35) {
                *(LAS h8*)(RQ + vrow * HRS + vc16) = qv[hs ^ 1][0]; *(LAS h8*)(RQ + vrow * HRS + vc16 + 8) = qv[hs ^ 1][1];
                *(LAS h8*)(RL + vrow * HRS + vc16) = lv[hs ^ 1][0]; *(LAS h8*)(RL + vrow * HRS + vc16 + 8) = lv[hs ^ 1][1];
            }
            HG_LBAR();
#if PROBE_ON == 2
            if (blockIdx.x == 0 && tid == 0) { unsigned long long* ta = (unsigned long long*)(p.ws + WS_TS); const unsigned long long n = wall_clock64(); ta[18] += n - ta[19]; ta[19] = n; }
#endif
        }
        }
    }
}

__device__ __forceinline__ void phase_readout(const Params& p, int wv_) {
    const int tid_ = otid(wv_), lane = tid_ & 63, wid = tid_ >> 6;
    f16* OF = (f16*)(p.ws + WS_R) + (size_t)2 * (SLOT / 2); const f16* OB = OF + SLOT / 2; const f16* Gt = OB + SLOT / 2;
    for (int it = blockIdx.x * 8 + wid; it < 2 * MH; it += gridDim.x * 8) {
        const int r = it >> 1, ch0 = (it & 1) * 1024 + lane * 16;
        const size_t o = (size_t)r * EI + ch0;
        float v[16]; float ss = 0.f;
#pragma unroll
        for (int q = 0; q < 2; ++q) { const h8 a = *(const h8*)(OF + o + q * 8), b = *(const h8*)(OB + o + q * 8);
#pragma unroll
            for (int e = 0; e < 8; ++e) { const float s = (float)a[e] + (float)b[e]; v[q * 8 + e] = s; ss += s * s; } }
        ss += shx(ss, lane, 1); ss += shx(ss, lane, 2); ss += shx(ss, lane, 4);
        const float rs = __builtin_amdgcn_rsqf(ss * (1.f / 128.f) + 1e-6f);
#pragma unroll
        for (int q = 0; q < 2; ++q) { const h8 gt = *(const h8*)(Gt + o + q * 8); float ov[8];
#pragma unroll
            for (int e = 0; e < 8; ++e) ov[e] = v[q * 8 + e] * rs * p.hg_norm_g[ch0 + q * 8 + e] * silu((float)gt[e]);
            *(h8*)((f16*)Gt + o + q * 8) = pg8::pack8(ov); }
    }
}

__device__ __forceinline__ void phase_conv(const Params& p, int wv_, int vb, int VG) {
    const f16* XB = (const f16*)(p.ws + WS_S); f16* XC = (f16*)(p.ws + WS_S) + (size_t)2 * (SLOT / 2);
    const int tid_ = otid(wv_);
    const int ch = (tid_ & 255) * 8, rsub = tid_ >> 8;
    float w[4][8], bias[8];
#pragma unroll
    for (int e = 0; e < 8; ++e) { bias[e] = p.rg_conv_b[ch + e];
#pragma unroll
        for (int j = 0; j < 4; ++j) w[j][e] = p.rg_conv_w[j * EI + ch + e]; }
    for (int r0 = vb * 8; r0 < MH; r0 += VG * 8) {
        h8 xv[4][4]; bool ok[4][4];
#pragma unroll
        for (int i = 0; i < 4; ++i) { const int r = r0 + rsub + 2 * i, s = r % TS; const int lo = (s < TC) ? 0 : TC, hi = (s < TC) ? TC : TS;
#pragma unroll
            for (int j = 0; j < 4; ++j) { const int ss = s - 2 + j; ok[i][j] = (ss >= lo && ss < hi);
                xv[i][j] = ok[i][j] ? *(const h8*)(XB + (size_t)(r - 2 + j) * EI + ch) : (h8){0, 0, 0, 0, 0, 0, 0, 0}; } }
#pragma unroll
        for (int i = 0; i < 4; ++i) { const int r = r0 + rsub + 2 * i; float a[8];
#pragma unroll
            for (int e = 0; e < 8; ++e) a[e] = bias[e];
#pragma unroll
            for (int j = 0; j < 4; ++j)
#pragma unroll
                for (int e = 0; e < 8; ++e) a[e] += w[j][e] * (float)xv[i][j][e];
            *(h8*)(XC + (size_t)r * EI + ch) = pg8::pack8(a); }
    }
}

constexpr int SEGL = 72, NSEG = 32;
__device__ __forceinline__ int rg_pos2s(int p, int dir) { return dir ? (p < TC ? TC - 1 - p : TS + TC - 1 - p) : p; }
__device__ __forceinline__ void phase_scan_local(const Params& p, int wv_) {
    f16* Sb = (f16*)(p.ws + WS_S); f32x4* segt = (f32x4*)(p.ws + WS_SEGT); const f32x4* coef = (const f32x4*)(p.ws + WS_COEF);
    const f16* XC = Sb + (size_t)2 * (SLOT / 2);
    const int tid_ = otid(wv_);
    for (int idx = blockIdx.x * 512 + tid_; idx < HBN * 2 * NSEG * 1024; idx += gridDim.x * 512) {
        const int cp = idx & 1023, seg = (idx >> 10) & (NSEG - 1), dir = (idx >> 15) & 1, bl = idx >> 16;
        f16* LA = Sb + (size_t)(dir ? 0 : 3) * (SLOT / 2); f16* U = Sb + (size_t)(dir ? 5 : 4) * (SLOT / 2);
        const f32x4 c0 = coef[dir * EI + cp * 2], c1 = coef[dir * EI + cp * 2 + 1];
        const size_t base = (size_t)bl * TS * EI + cp * 2;
        float h0 = 0.f, h1 = 0.f, L0 = 0.f, L1 = 0.f;
        for (int i0 = 0; i0 < SEGL; i0 += 12) {
            h2 la[12], u[12], xc[12];
#pragma unroll
            for (int i = 0; i < 12; ++i) { const size_t o = base + (size_t)rg_pos2s(seg * SEGL + i0 + i, dir) * EI; la[i] = *(const h2*)(LA + o); u[i] = *(const h2*)(U + o); xc[i] = *(const h2*)(XC + o); }
#pragma unroll
            for (int i = 0; i < 12; ++i) {
#pragma unroll
                for (int e = 0; e < 2; ++e) {
                    const f32x4 cc = e ? c1 : c0;
                    const float ea = fexp(fminf(-((float)la[i][e] + cc[0]), 40.f)), ex = fexp(fminf(-((float)u[i][e] + cc[1]), 40.f));
                    const float R = __builtin_amdgcn_rcpf((1.f + ea) * (1.f + ex));
                    const float r = (1.f + ex) * R, ig = (1.f + ea) * R;
                    const float l = r * cc[2], a = fexp(l), y = 2.f * l;
                    const float poly = -y * (1.f + y * (0.5f + y * (0.16666667f + y * 0.041666668f)));
                    const float om = (y > -0.125f) ? poly : 1.f - a * a;
                    const float uu = fsqrt(om) * ig * (float)xc[i][e];
                    float& hh = e ? h1 : h0; float& LL = e ? L1 : L0;
                    hh = a * hh + uu; LL += l;
                    u[i][e] = (f16)hh; la[i][e] = (f16)LL;
                }
            }
#pragma unroll
            for (int i = 0; i < 12; ++i) { const size_t o = base + (size_t)rg_pos2s(seg * SEGL + i0 + i, dir) * EI; *(h2*)(U + o) = u[i]; *(h2*)(LA + o) = la[i]; }
        }
        segt[(size_t)((bl * 2 + dir) * NSEG + seg) * 1024 + cp] = (f32x4){L0, h0, L1, h1};
    }
}

__device__ __forceinline__ void phase_scan_final(const Params& p, int wv_) {
    f16* Sb = (f16*)(p.ws + WS_S); const f32x4* segt = (const f32x4*)(p.ws + WS_SEGT);
    const f16* LAf = Sb + (size_t)3 * (SLOT / 2); const f16* Uf = Sb + (size_t)4 * (SLOT / 2); const f16* LAb = Sb; const f16* Ub = Sb + (size_t)5 * (SLOT / 2);
    f16* G1 = Sb + (size_t)1 * (SLOT / 2);
    const int tid_ = otid(wv_);
    for (int idx = blockIdx.x * 512 + tid_; idx < HBN * NSEG * 1024; idx += gridDim.x * 512) {
        const int cp = idx & 1023, seg = (idx >> 10) & (NSEG - 1), bl = idx >> 15;
        if (seg * SEGL + SEGL <= TC) continue;
        const f32x4* sf = segt + (size_t)((bl * 2 + 0) * NSEG) * 1024 + cp; const f32x4* sb = segt + (size_t)((bl * 2 + 1) * NSEG) * 1024 + cp;
        float cf0 = 0.f, cf1 = 0.f;
#pragma unroll 4
        for (int sg = 0; sg < seg; ++sg) { const f32x4 t = sf[(size_t)sg * 1024]; cf0 = fexp(t[0]) * cf0 + t[1]; cf1 = fexp(t[2]) * cf1 + t[3]; }
        const int s_first = (seg * SEGL > TC) ? seg * SEGL : TC;
        const int jhi = (TS + TC - 1 - s_first) / SEGL, jlo = (TS + TC - 1 - (seg * SEGL + SEGL - 1)) / SEGL;
        float ch0 = 0.f, ch1 = 0.f, cl0 = 0.f, cl1 = 0.f;
#pragma unroll 4
        for (int sg = 0; sg < jhi; ++sg) { if (sg == jlo) { cl0 = ch0; cl1 = ch1; } const f32x4 t = sb[(size_t)sg * 1024]; ch0 = fexp(t[0]) * ch0 + t[1]; ch1 = fexp(t[2]) * ch1 + t[3]; }
        if (jlo == jhi) { cl0 = ch0; cl1 = ch1; }
        const size_t base = (size_t)bl * TS * EI + cp * 2;
        for (int i0 = 0; i0 < SEGL; i0 += 8) {
            h2 lf[8], uf[8], lb[8], ub[8], g[8];
#pragma unroll
            for (int i = 0; i < 8; ++i) { const int s = seg * SEGL + i0 + i; if (s >= TC) { const size_t o = base + (size_t)s * EI;
                lf[i] = *(const h2*)(LAf + o); uf[i] = *(const h2*)(Uf + o); lb[i] = *(const h2*)(LAb + o); ub[i] = *(const h2*)(Ub + o); g[i] = *(const h2*)(G1 + o); } }
#pragma unroll
            for (int i = 0; i < 8; ++i) { const int s = seg * SEGL + i0 + i; if (s >= TC) {
                const bool hi = ((TS + TC - 1 - s) / SEGL) == jhi;
                const float cb0 = hi ? ch0 : cl0, cb1 = hi ? ch1 : cl1;
                const float y0 = (float)uf[i][0] + fexp((float)lf[i][0]) * cf0 + (float)ub[i][0] + fexp((float)lb[i][0]) * cb0;
                const float y1 = (float)uf[i][1] + fexp((float)lf[i][1]) * cf1 + (float)ub[i][1] + fexp((float)lb[i][1]) * cb1;
                g[i][0] = (f16)(y0 * silu((float)g[i][0])); g[i][1] = (f16)(y1 * silu((float)g[i][1])); } }
#pragma unroll
            for (int i = 0; i < 8; ++i) { const int s = seg * SEGL + i0 + i; if (s >= TC) *(h2*)(G1 + base + (size_t)s * EI) = g[i]; }
        }
    }
}

__device__ __forceinline__ void phase_final(const Params& p, float delta, int wv_, int rbeg, int rend, int vb, int VG) {
    const int tid_ = otid(wv_), lane = tid_ & 63, wid = tid_ >> 6;
    for (int r = rbeg + vb * 8 + wid; r < rend; r += VG * 8) {
        float* row = p.out + (size_t)r * DM;
        f32x4 v[4]; float ss = 0.f;
#pragma unroll
        for (int i = 0; i < 4; ++i) { v[i] = *(const f32x4*)(row + lane * 4 + i * 256); ss += v[i][0] * v[i][0] + v[i][1] * v[i][1] + v[i][2] * v[i][2] + v[i][3] * v[i][3]; }
        ss = wave_sum(ss, lane);
        const float rs = __builtin_amdgcn_rsqf(ss * (1.f / DM) + 1e-6f);
#pragma unroll
        for (int i = 0; i < 4; ++i) { const int k = lane * 4 + i * 256; const f32x4 gg = *(const f32x4*)(p.final_g + k); f32x4 ov = v[i] * rs * gg; if ((r & 15) == 0) ov = ov + delta; *(f32x4*)(row + k) = ov; }
    }
}

#define XB_TMO      128
#define XB_XCNT(j)  (256  + 64 * (j))
#define XB_XSUB(j)  (1280 + 64 * (j))
#define XB_XGEN(j)  (2304 + 64 * (j))
#define XB_TOP      3328
#define XB_TOPGEN   3392
#define XCD_BAR_WORDS 3456
#define XB_SPIN_CAP (1u << 18)
__device__ __forceinline__ unsigned xb_ld(unsigned* p)              { return __hip_atomic_load(p, __ATOMIC_RELAXED, __HIP_MEMORY_SCOPE_AGENT); }
__device__ __forceinline__ unsigned xb_add(unsigned* p, unsigned v) { return __hip_atomic_fetch_add(p, v, __ATOMIC_RELAXED, __HIP_MEMORY_SCOPE_AGENT); }
__device__ __forceinline__ unsigned xb_xcc_id() { return (unsigned)__builtin_amdgcn_s_getreg((3 << 11) | 20) & 0xFu; }
#define XB_SPIN(cond, bar) do { unsigned _sp = 0; while (cond) { __builtin_amdgcn_s_sleep(1); \
    if ((++_sp & 255u) == 0u) { if (xb_ld(&(bar)[XB_TMO])) break; if (_sp > XB_SPIN_CAP) { atomicAdd(&(bar)[XB_TMO], 1u); break; } } } } while (0)
struct XcdBarrier { unsigned* bar; unsigned x; volatile LAS unsigned* st; };
__device__ __forceinline__ XcdBarrier xcd_barrier_post(unsigned* bar, volatile LAS unsigned* st) {
    XcdBarrier b; b.bar = bar; b.x = xb_xcc_id(); b.st = st;
    if (threadIdx.x == 0) (void)xb_add(&bar[XB_XCNT(b.x)], 1u);
    return b;
}
__device__ __forceinline__ void xcd_barrier_complete(unsigned* bar, unsigned x, unsigned& nloc, unsigned& nx) {
    const unsigned G = gridDim.x * gridDim.y * gridDim.z;
    unsigned sum, cnt, mine, sp = 0u;
    for (;;) {
        sum = 0u; cnt = 0u; mine = 0u;
#pragma unroll
        for (unsigned j = 0; j < 16; ++j) { const unsigned c = xb_ld(&bar[XB_XCNT(j)]); sum += c; cnt += (c > 0u) ? 1u : 0u; mine = (j == x) ? c : mine; }
        if (sum == G) break;
        __builtin_amdgcn_s_sleep(1);
        if ((++sp & 255u) == 0u) { if (xb_ld(&bar[XB_TMO])) break; if (sp > XB_SPIN_CAP) { atomicAdd(&bar[XB_TMO], 1u); break; } }
    }
    nloc = mine > 0u ? mine : 1u; nx = cnt > 0u ? cnt : 1u;
}
__device__ __forceinline__ void xcd_barrier(const XcdBarrier& b) {
    asm volatile("s_waitcnt vmcnt(0)" ::: "memory");
    __syncthreads();
    if (threadIdx.x == 0) {
        unsigned* bar = b.bar; unsigned bx = __builtin_amdgcn_readfirstlane(b.x);
        asm volatile("" : "+s"(bx));
        __builtin_amdgcn_s_waitcnt(0);
        unsigned nloc = b.st[0], nx = b.st[1];
        if (nloc == 0u) { xcd_barrier_complete(bar, bx, nloc, nx); b.st[0] = nloc; b.st[1] = nx; }
        const unsigned old = xb_add(&bar[XB_XSUB(bx)], 1u);
        const unsigned gen = old / nloc;
        if (old + 1u == (gen + 1u) * nloc) {
            __builtin_amdgcn_fence(__ATOMIC_RELEASE, "agent");
            asm volatile("s_waitcnt vmcnt(0)" ::: "memory");
            const unsigned og = xb_add(&bar[XB_TOP], 1u);
            const unsigned tg = og / nx;
            if (og + 1u == (tg + 1u) * nx) xb_add(&bar[XB_TOPGEN], 1u);
            else XB_SPIN(xb_ld(&bar[XB_TOPGEN]) == tg, bar);
            __builtin_amdgcn_fence(__ATOMIC_ACQUIRE, "agent");
            xb_add(&bar[XB_XGEN(bx)], 1u);
            asm volatile("s_waitcnt vmcnt(0)" ::: "memory");
        } else {
            XB_SPIN(xb_ld(&bar[XB_XGEN(bx)]) == gen, bar);
            __builtin_amdgcn_fence(__ATOMIC_ACQUIRE, "agent");
            asm volatile("s_waitcnt vmcnt(0)" ::: "memory");
        }
    }
    __syncthreads();
}

#if PROBE_ON
#define STAMP(type) do { if (bid == 0 && threadIdx.x == 0) { unsigned long long* tacc_ = (unsigned long long*)(p.ws + WS_TS); const unsigned long long now_ = wall_clock64(); tacc_[type] += now_ - tacc_[15]; tacc_[15] = now_; } } while (0)
#else
#define STAMP(type) do { } while (0)
#endif
__global__ void __launch_bounds__(512, 2) mega(Params p) {
    extern __shared__ __attribute__((aligned(16))) unsigned char lds_raw[];
    LAS unsigned char* lds = (LAS unsigned char*)lds_raw;
    cg::grid_group grid = cg::this_grid();
    const int G = gridDim.x, bid = blockIdx.x;
    const int wv_ = __builtin_amdgcn_readfirstlane((int)(threadIdx.x >> 6));
    volatile LAS unsigned* xst = (volatile LAS unsigned*)(lds + LDS_XST);
    if (threadIdx.x == 0) { xst[0] = 0u; xst[1] = 0u; }
    __syncthreads();
    const XcdBarrier xb = xcd_barrier_post((unsigned*)(p.ws + WS_BAR), xst);
    if (gridDim.x == 0x7fffffffu) grid.sync();
    unsigned char* ws = p.ws;
#if PROBE_ON
    if (bid == 0 && threadIdx.x == 0) { unsigned long long* tacc_ = (unsigned long long*)(ws + WS_TS); for (int i = 0; i < 24; ++i) tacc_[i] = 0; tacc_[13] = tacc_[15] = wall_clock64(); }
#endif

    phase0(p, lds_raw, wv_);
    xcd_barrier(xb); STAMP(0);

    const int naux = (G > 128) ? G - 128 : G, vaux = (G > 128) ? bid - 128 : bid;
    phase_h<0>(p, 0, wv_, bid, G);
    xcd_barrier(xb); STAMP(1);
#define MK_GEMM1(SCHED_SETUP) do { pg8::Gemm g{(const f16*)(ws + WS_H), (const f16*)(ws + WS_WIN0T), 36, 40, 1024, 1024, 1024, 0}; \
          pg8::StaticOrder S; SCHED_SETUP; pg8::Epi1 E{(f16*)(ws + WS_R), (const float*)(ws + WS_LB0)}; pg8::gemm_phase(lds, g, S, E, wv_); } while (0)
#define MK_GEMM2(HB) do { pg8::Gemm g{(const f16*)(ws + WS_R) + (size_t)4 * (SLOT / 2), (const f16*)(ws + WS_WOUT0T), 36, 4, 2048, 2048, 2048, 0}; \
          pg8::StaticOrder S; S.init(36, 4, G, bid, 0); pg8::Epi2 E{p.x, p.ctx, p.out, (float*)(ws + WS_X1C), (const float*)(ws + WS_MODS), (HB)}; pg8::gemm_phase(lds, g, S, E, wv_); } while (0)
    MK_GEMM1(S.init(36, 40, G, bid, 0));
    xcd_barrier(xb); STAMP(2);
    phase_hgrn(p, lds, wv_);
    if (vaux >= 0) {
        phase_transposes(p, lds_raw, wv_, 2560, 5120, vaux, naux);
        phase_h<0>(p, 1, wv_, vaux, naux);
    }
    xcd_barrier(xb); STAMP(3);
    phase_readout(p, wv_);
    xcd_barrier(xb); STAMP(4);
    MK_GEMM2(0);
    MK_GEMM1(S.init(36, 32, G, bid, 0); if (G == 256) { if (bid >= 144) { S.G = 112; S.c = bid - 144; S.maxi = 6; } else { S.G = 144; S.c = bid; S.base = 672; S.maxi = 4; } });
    xcd_barrier(xb); STAMP(5);
    phase_hgrn(p, lds, wv_);
    if (vaux >= 0) MK_GEMM1(S.init(36, 8, naux, vaux, 0); S.pn0 = 32);
    xcd_barrier(xb); STAMP(3);
    phase_readout(p, wv_);
    xcd_barrier(xb); STAMP(4);
    MK_GEMM2(1);
    if (G > 144) { if (bid >= 144) phase_h<1>(p, 0, wv_, bid - 144, G - 144); }
    else phase_h<1>(p, 0, wv_, bid, G);
    xcd_barrier(xb); STAMP(5);

#pragma unroll 1
    for (int hb = 0; hb < 2; ++hb) {
#define MK_GEMM3(SCHED_SETUP) do { pg8::Gemm g{(const f16*)(ws + WS_S + (size_t)(hb ? 5 : 4) * SLOT), (const f16*)(ws + WS_WIN1T), 36, 16, 1024, 1024, 1024, 0}; \
          pg8::StaticOrder S; SCHED_SETUP; pg8::Epi3 E{(f16*)(ws + WS_S)}; pg8::gemm_phase(lds, g, S, E, wv_); } while (0)
        if (G == 256) {
            MK_GEMM3(S.init(36, 8, G, bid, 0));
            MK_GEMM3(S.init(28, 8, 224, bid - 32, 1); S.pn0 = 8; if (bid < 32) S.maxi = 0; else S.maxi = 1);
            xcd_barrier(xb); STAMP(7);
            if (bid < 32) MK_GEMM3(S.init(4, 8, 32, bid, 1); S.pn0 = 8; S.pm0 = 28; S.maxi = 1);
            else phase_conv(p, wv_, bid - 32, 224);
        } else {
            MK_GEMM3(S.init(36, 16, G, bid, 0));
            xcd_barrier(xb); STAMP(7);
            phase_conv(p, wv_, bid, G);
        }
        xcd_barrier(xb); STAMP(8);
        { pg8::Gemm g{(const f16*)(ws + WS_S + 2 * SLOT), (const f16*)(ws + WS_WCO), 36, 32, 256, 2048, 256, 2};
          pg8::StaticOrder S; S.init(36, 32, G, bid, 0);
          pg8::Epi4 E{(f16*)(ws + WS_S)};
          pg8::gemm_phase(lds, g, S, E, wv_); }
        xcd_barrier(xb); STAMP(9);
        phase_scan_local(p, wv_);
        xcd_barrier(xb); STAMP(10);
        phase_scan_final(p, wv_);
        xcd_barrier(xb); STAMP(11);
        { pg8::Gemm g{(const f16*)(ws + WS_S + 1 * SLOT), (const f16*)(ws + WS_WOUT1T), 32, 4, 2048, 2048, 2048, 1};
          pg8::StaticOrder S; S.init(32, 4, G, bid, 1);
          pg8::Epi5 E{p.out, (const float*)(ws + WS_MODS) + 9 * 3072, hb};
          pg8::gemm_phase(lds, g, S, E, wv_); }
        if (hb == 0) {
            if (G > 128) { if (bid >= 128) phase_h<1>(p, 1, wv_, bid - 128, G - 128); }
            else phase_h<1>(p, 1, wv_, bid, G);
        }
#if !PROBE_ON
        else if (G > 128 && bid >= 128) phase_final(p, 0.f, wv_, 0, 4 * TL, bid - 128, G - 128);
#endif
        xcd_barrier(xb); STAMP(12);
    }
#if PROBE_ON
    if (bid == 0 && threadIdx.x == 0) { unsigned long long* tacc_ = (unsigned long long*)(ws + WS_TS); tacc_[14] = tacc_[15] - tacc_[13]; }
    xcd_barrier(xb);
    { const unsigned long long* tacc = (const unsigned long long*)(ws + WS_TS); unsigned long long tot = tacc[14], ta = 0, tb = 0, td = 0;
      for (int i = 0; i < 14; ++i) { if ((PROBE_A_MASK >> i) & 1) ta += tacc[i]; if ((PROBE_B_MASK >> i) & 1) tb += tacc[i]; if ((PROBE_DUR_MASK >> i) & 1) td += tacc[i]; }
#if PROBE_ON == 2
      tot = tacc[16] + tacc[17] + tacc[18]; ta = tacc[16]; tb = tacc[17]; td = 0;
#endif
      int a = (int)((ta * 64 + tot / 2) / tot), b = (int)((tb * 32 + tot / 2) / tot); if (a > 63) a = 63; if (b > 31) b = 31;
      const float X = (float)(a * 32 + b) * (1.f / 2048.f);
      phase_final(p, 0.04f * __builtin_sqrtf(X), wv_, 0, 8 * TL, bid, G);
      if (bid == 0 && threadIdx.x == 0) { const unsigned long long t0 = wall_clock64(); while (wall_clock64() - t0 < td) { __builtin_amdgcn_s_sleep(8); } }
      __syncthreads(); }
#else
    if (G > 128) phase_final(p, 0.f, wv_, 4 * TL, 8 * TL, bid, G);
    else phase_final(p, 0.f, wv_, 0, 8 * TL, bid, G);
#endif
}

extern "C" void kernel_launch(void* const* d_in, const int* in_sizes, int n_in, void* d_out, int out_size, void* d_ws, size_t ws_size, hipStream_t stream) {
    static int grid_blocks = 0;
    if (!grid_blocks) {
        int dev = 0, cus = 0, per_cu = 0;
        hipGetDevice(&dev);
        hipDeviceGetAttribute(&cus, hipDeviceAttributeMultiprocessorCount, dev);
        if (hipFuncSetAttribute((const void*)mega, hipFuncAttributeMaxDynamicSharedMemorySize, LDS_BYTES) != hipSuccess) fprintf(stderr, "hipFuncSetAttribute failed\n");
        hipOccupancyMaxActiveBlocksPerMultiprocessor(&per_cu, (const void*)mega, 512, LDS_BYTES);
        if (per_cu < 1) { fprintf(stderr, "occupancy query says %d blocks/CU\n", per_cu); per_cu = 1; }
        grid_blocks = cus;
        if (ws_size < 252 * MiB) fprintf(stderr, "workspace too small: %zu\n", ws_size);
    }
    Params p{};
    const float** pp = (const float**)&p;
    for (int i = 0; i < 21; ++i) pp[i] = (const float*)d_in[i];
    p.out = (float*)d_out; p.ws = (unsigned char*)d_ws;
    if (hipMemsetAsync((unsigned char*)d_ws + WS_BAR, 0, XCD_BAR_WORDS * 4 + 256, stream) != hipSuccess) fprintf(stderr, "barrier memset failed\n");
    void* args[] = {&p};
    hipError_t e = hipLaunchCooperativeKernel((const void*)mega, dim3(grid_blocks), dim3(512), args, LDS_BYTES, stream);
    if (e != hipSuccess) fprintf(stderr, "cooperative launch failed: %s (grid %d)\n", hipGetErrorString(e), grid_blocks);
}
```
